# Optimizing an MI355X kernel written in HIP

```python
import math
import jax, jax.numpy as jnp
from jax import lax
import numpy as np

D_MODEL = 1024
BATCH = 8
SEQ = 4096
DEPTH = 2

GRID_W = 64
CTX_LEN = 256
EPS = 1e-6
ROPE_BASE = 10000.0
MIX_WIDTH = D_MODEL
HALF_MIX = MIX_WIDTH // 2
SHORT_CONV_W = 5

A_HEAD_DIM = 64
A_HEADS = HALF_MIX // A_HEAD_DIM
A_KV_HEADS = A_HEADS // 4
A_GROUP = A_HEADS // A_KV_HEADS
A_WINDOW = 128
A_BLOCK = 128

B_HEADS = 4
B_V_DIM = HALF_MIX // B_HEADS
B_QK_DIM = B_V_DIM // 2
B_CHUNK = 64

C_HEAD_DIM = 64
C_HEADS = HALF_MIX // (2 * C_HEAD_DIM)
C_BLOCK = 128

D_HEAD_DIM = 64
D_HEADS = HALF_MIX // D_HEAD_DIM
D_GROUPS = 2
D_STATE = 128
D_CHUNK = 128

FFN_HIDDEN = ((8 * D_MODEL // 3 + 255) // 256) * 256
FFN_CONV_W = 3

A_Q = A_HEADS * A_HEAD_DIM
A_KV = A_KV_HEADS * A_HEAD_DIM
B_QK = 2 * B_HEADS * B_QK_DIM
B_V = B_HEADS * B_V_DIM
B_GATES = 4 * B_HEADS
C_QK = C_HEADS * 2 * C_HEAD_DIM
C_V = C_HEADS * 2 * C_HEAD_DIM
D_INNER = D_HEADS * D_HEAD_DIM
D_XBC = D_INNER + 2 * D_GROUPS * D_STATE
EVEN_SIZES = (A_Q, A_KV, A_KV, B_QK, B_V, B_V, B_GATES)
ODD_SIZES = (C_QK, C_QK, C_V, D_INNER, D_XBC, 2 * D_HEADS)
EVEN_IN = sum(EVEN_SIZES)
ODD_IN = sum(ODD_SIZES)

kernel_name = 'hybrid_diffusion_gqa_mlstm_diffattn_ssd'


def rmsnorm(x, g):
    xf = x.astype(jnp.float32)
    y = xf * lax.rsqrt(jnp.mean(xf * xf, axis=-1, keepdims=True) + EPS)
    return (y * g.astype(jnp.float32)).astype(x.dtype)


def modulate(u, shift, scale):
    return u * (1.0 + scale) + shift


def split_cols(y, sizes):
    return jnp.split(y, [int(s) for s in np.cumsum(sizes)[:-1]], axis=-1)


def dwconv(x, w):
    k = w.shape[0]
    pad = k // 2
    t = x.shape[1]
    xp = jnp.pad(x, ((0, 0), (pad, pad), (0, 0)))
    y = xp[:, 0:t] * w[0]
    for j in range(1, k):
        y = y + xp[:, j:j + t] * w[j]
    return y


def axial_rope_tables(rows, head_dim):
    pos = jnp.arange(rows * GRID_W)
    row = (pos // GRID_W).astype(jnp.float32)
    col = (pos % GRID_W).astype(jnp.float32)
    nf = head_dim // 4
    inv = ROPE_BASE ** (-jnp.arange(nf, dtype=jnp.float32) / nf)
    ar = row[:, None] * inv
    ac = col[:, None] * inv
    return (jnp.cos(ar), jnp.sin(ar), jnp.cos(ac), jnp.sin(ac))


def _rot_half(x, cos, sin):
    x1, x2 = jnp.split(x, 2, axis=-1)
    return jnp.concatenate([x1 * cos - x2 * sin, x2 * cos + x1 * sin], axis=-1)


def rope_2d(x, tabs):
    def shape(t):
        return t.reshape(t.shape[:1] + (1,) * (x.ndim - 3) + t.shape[1:]).astype(x.dtype)
    cr, sr, cc, sc = (shape(t) for t in tabs)
    xr, xc = jnp.split(x, 2, axis=-1)
    return jnp.concatenate([_rot_half(xr, cr, sr), _rot_half(xc, cc, sc)], axis=-1)


def _flip_time(arrays):
    return tuple(jnp.flip(a, axis=1) for a in arrays)


def bidir(run, ctx_dirs, lat_dirs, zero_state, need_ctx):
    y_ctx, y_lat = None, None
    for d in range(2):
        ci, li = ctx_dirs[d], lat_dirs[d]
        if d == 1:
            ci, li = _flip_time(ci), _flip_time(li)
        yc, state = run(*ci, zero_state, need_ctx)
        yl, _ = run(*li, state, True)
        if d == 1:
            yl = jnp.flip(yl, axis=1)
            yc = jnp.flip(yc, axis=1) if need_ctx else None
        y_lat = yl if y_lat is None else y_lat + yl
        if need_ctx:
            y_ctx = yc if y_ctx is None else y_ctx + yc
    return y_ctx, y_lat


def mlstm_chunked(q, k, v, log_i, log_f, state, want_out):
    bsz, t, nh, _ = q.shape
    L = B_CHUNK
    nc = t // L

    def ch(a):
        return a.reshape((bsz, nc, L) + a.shape[2:])
    q, k, v = ch(q), ch(k), ch(v)
    li = jnp.swapaxes(ch(log_i), 2, 3)
    b = jnp.cumsum(jnp.swapaxes(ch(log_f), 2, 3), axis=-1)
    b_last = b[..., -1]
    w = b_last[..., None] - b + li
    m_loc = jnp.max(w, axis=-1)
    e = jnp.exp(w - m_loc[..., None])
    c_loc = jnp.einsum('bchl,bclhv,bclhk->bchvk', e, v, k)
    n_loc = jnp.einsum('bchl,bclhk->bchk', e, k)

    def step(carry, inp):
        c_prev, n_prev, m_prev = carry
        bl, cl, nl, ml = inp
        m_new = jnp.maximum(bl + m_prev, ml)
        a = jnp.exp(bl + m_prev - m_new)
        g = jnp.exp(ml - m_new)
        c_new = a[..., None, None] * c_prev + g[..., None, None] * cl
        n_new = a[..., None] * n_prev + g[..., None] * nl
        return (c_new, n_new, m_new), (c_prev, n_prev, m_prev)

    lead = lambda a: jnp.moveaxis(a, 1, 0)
    final, (c0, n0, m0) = lax.scan(step, state, (lead(b_last), lead(c_loc), lead(n_loc), lead(m_loc)))
    if not want_out:
        return None, final
    c0, n0, m0 = jnp.moveaxis(c0, 0, 1), jnp.moveaxis(n0, 0, 1), jnp.moveaxis(m0, 0, 1)
    tri = jnp.tril(jnp.ones((L, L), dtype=bool))
    log_d = jnp.where(tri, b[..., :, None] - b[..., None, :] + li[..., None, :], -jnp.inf)
    g_in = b + m0[..., None]
    m_t = jnp.maximum(jnp.max(log_d, axis=-1), g_in)
    s = jnp.einsum('bcthk,bcshk->bchts', q, k) * jnp.exp(log_d - m_t[..., None])
    a_in = jnp.exp(g_in - m_t)
    num = jnp.einsum('bchts,bcshv->bcthv', s, v) + jnp.einsum('bcht,bchvk,bcthk->bcthv', a_in, c0, q)
    den = jnp.sum(s, axis=-1) + a_in * jnp.einsum('bchk,bcthk->bcht', n0, q)
    den = jnp.maximum(jnp.abs(den), jnp.exp(-m_t))
    h = num / jnp.swapaxes(den, 2, 3)[..., None]
    return h.reshape(bsz, t, nh, -1), final


def ssd_chunked(x, dt, a, bm, cm, state, want_out):
    bsz, t = x.shape[:2]
    L = D_CHUNK
    nc = t // L

    def ch(z):
        return z.reshape((bsz, nc, L) + z.shape[2:])
    x, dt, a, bm, cm = ch(x), ch(dt), ch(a), ch(bm), ch(cm)
    acum = jnp.cumsum(a, axis=2)
    a_last = acum[:, :, -1]
    wst = jnp.exp(a_last[:, :, None] - acum) * dt
    s_loc = jnp.einsum('bclgh,bclgn,bclghp->bcghpn', wst, bm, x)

    def step(h, inp):
        da, sl = inp
        return jnp.exp(da)[..., None, None] * h + sl, h

    final, h0 = lax.scan(step, state, (jnp.moveaxis(a_last, 1, 0), jnp.moveaxis(s_loc, 1, 0)))
    if not want_out:
        return None, final
    h0 = jnp.moveaxis(h0, 0, 1)
    ac = jnp.moveaxis(acum, 2, -1)
    tri = jnp.tril(jnp.ones((L, L), dtype=bool))
    seg = jnp.where(tri, ac[..., :, None] - ac[..., None, :], -jnp.inf)
    cb = jnp.einsum('bctgn,bcsgn->bcgts', cm, bm)
    mix = cb[:, :, :, None] * jnp.exp(seg) * jnp.moveaxis(dt, 2, -1)[..., None, :]
    y = jnp.einsum('bcghts,bcsghp->bctghp', mix, x)
    y = y + jnp.einsum('bctgn,bcghpn->bctghp', cm, h0) * jnp.exp(acum)[..., None]
    return y.reshape((bsz, t) + y.shape[3:]), final


def windowed_gqa_latent(q, k, v, k_ctx, v_ctx, sink):
    bsz, t = q.shape[:2]
    w = A_BLOCK
    nb = t // w
    scale = A_HEAD_DIM ** -0.5

    def windows(z):
        zp = jnp.pad(z, ((0, 0), (w, w), (0, 0), (0, 0))).reshape(bsz, nb + 2, w, A_KV_HEADS, A_HEAD_DIM)
        return jnp.concatenate([zp[:, :-2], zp[:, 1:-1], zp[:, 2:]], axis=2)
    kw, vw = windows(k), windows(v)
    qb = q.reshape(bsz, nb, w, A_KV_HEADS, A_GROUP, A_HEAD_DIM)
    s_loc = jnp.einsum('bnqhgd,bnkhd->bnhgqk', qb, kw).astype(jnp.float32) * scale
    qi = jnp.arange(w)[:, None]
    kj = jnp.arange(3 * w)[None, :]
    kpos = (jnp.arange(nb) * w)[:, None, None] - w + kj[None]
    mask = (jnp.abs(kj - w - qi) <= A_WINDOW)[None] & (kpos >= 0) & (kpos < t)
    s_loc = jnp.where(mask[None, :, None, None], s_loc, -jnp.inf)
    s_ctx = jnp.einsum('bnqhgd,bchd->bnhgqc', qb, k_ctx).astype(jnp.float32) * scale
    s_sink = jnp.broadcast_to(sink.astype(jnp.float32).reshape(A_KV_HEADS, A_GROUP, 1, 1), s_ctx.shape[:-1] + (1,))
    p = jax.nn.softmax(jnp.concatenate([s_loc, s_ctx, s_sink], axis=-1), axis=-1).astype(v.dtype)
    o = (jnp.einsum('bnhgqk,bnkhd->bnqhgd', p[..., :3 * w], vw)
         + jnp.einsum('bnhgqc,bchd->bnqhgd', p[..., 3 * w:-1], v_ctx))
    return o.reshape(bsz, t, A_Q)


def gqa_context(q, k, v, sink):
    bsz, tc = q.shape[:2]
    s = jnp.einsum('bqhgd,bkhd->bhgqk', q, k).astype(jnp.float32) * (A_HEAD_DIM ** -0.5)
    s_sink = jnp.broadcast_to(sink.astype(jnp.float32).reshape(A_KV_HEADS, A_GROUP, 1, 1), s.shape[:-1] + (1,))
    p = jax.nn.softmax(jnp.concatenate([s, s_sink], axis=-1), axis=-1)[..., :-1].astype(v.dtype)
    return jnp.einsum('bhgqk,bkhd->bqhgd', p, v).reshape(bsz, tc, A_Q)


def even_mixer(uc, ux, w_in, w_out, sink, conv_w, gate_b, norm_gain, rope, need_ctx):
    pc = split_cols(uc @ w_in, EVEN_SIZES)
    px = split_cols(ux @ w_in, EVEN_SIZES)
    bsz = ux.shape[0]

    def attn_heads(p):
        b_, t_ = p[0].shape[:2]
        return (p[0].reshape(b_, t_, A_KV_HEADS, A_GROUP, A_HEAD_DIM),
                p[1].reshape(b_, t_, A_KV_HEADS, A_HEAD_DIM),
                p[2].reshape(b_, t_, A_KV_HEADS, A_HEAD_DIM))
    qc, kc, vc = attn_heads(pc)
    qx, kx, vx = attn_heads(px)
    ya_x = windowed_gqa_latent(rope_2d(qx, rope), rope_2d(kx, rope), vx, kc, vc, sink)

    def mlstm_inputs(p):
        b_, t_ = p[3].shape[:2]
        q, k = jnp.split(jax.nn.silu(dwconv(p[3], conv_w)), 2, axis=-1)
        q = q.reshape(b_, t_, B_HEADS, B_QK_DIM).astype(jnp.float32) * (B_QK_DIM ** -0.5)
        k = k.reshape(b_, t_, B_HEADS, B_QK_DIM).astype(jnp.float32)
        v = p[4].reshape(b_, t_, B_HEADS, B_V_DIM).astype(jnp.float32)
        g = (p[6].astype(jnp.float32) + gate_b.astype(jnp.float32)).reshape(b_, t_, 4, B_HEADS)
        return tuple((q, k, v, g[:, :, d], jax.nn.log_sigmoid(g[:, :, 2 + d])) for d in range(2))

    zero = (jnp.zeros((bsz, B_HEADS, B_V_DIM, B_QK_DIM), jnp.float32),
            jnp.zeros((bsz, B_HEADS, B_QK_DIM), jnp.float32),
            jnp.zeros((bsz, B_HEADS), jnp.float32))
    hb_c, hb_x = bidir(mlstm_chunked, mlstm_inputs(pc), mlstm_inputs(px), zero, need_ctx)

    def mlstm_out(h, p):
        b_, t_ = p[5].shape[:2]
        o = jax.nn.sigmoid(p[5].reshape(b_, t_, B_HEADS, B_V_DIM))
        return (rmsnorm(h, norm_gain.reshape(B_HEADS, B_V_DIM)).astype(o.dtype) * o).reshape(b_, t_, B_V)

    yx = jnp.concatenate([ya_x, mlstm_out(hb_x, px)], axis=-1) @ w_out
    yc = None
    if need_ctx:
        ya_c = gqa_context(qc, kc, vc, sink)
        yc = jnp.concatenate([ya_c, mlstm_out(hb_c, pc)], axis=-1) @ w_out
    return yc, yx


def diff_attn(q, k, v, lam, scale):
    s = jnp.einsum('bqhmd,bkhmd->bhmqk', q, k).astype(jnp.float32) * scale
    p = jax.nn.softmax(s, axis=-1)
    a = (p[:, :, 0] - lam * p[:, :, 1]).astype(v.dtype)
    return jnp.einsum('bhqk,bkhv->bqhv', a, v)


def odd_mixer(uc, ux, w_in, w_out, lam_vecs, c_gain, conv_w, conv_b, dt_bias, a_log, skip, d_gain,
              rope, lam_init, need_ctx):
    pc = split_cols(uc @ w_in, ODD_SIZES)
    px = split_cols(ux @ w_in, ODD_SIZES)
    bsz, t = ux.shape[:2]

    def diff_heads(p):
        b_, t_ = p[0].shape[:2]
        return (p[0].reshape(b_, t_, C_HEADS, 2, C_HEAD_DIM),
                p[1].reshape(b_, t_, C_HEADS, 2, C_HEAD_DIM),
                p[2].reshape(b_, t_, C_HEADS, 2 * C_HEAD_DIM))
    qc, kc, vc = diff_heads(pc)
    qx, kx, vx = diff_heads(px)
    lv = lam_vecs.astype(jnp.float32)
    lam = jnp.exp(jnp.sum(lv[0] * lv[1])) - jnp.exp(jnp.sum(lv[2] * lv[3])) + lam_init
    scale = C_HEAD_DIM ** -0.5
    k_all = jnp.concatenate([rope_2d(kx, rope), kc], axis=1)
    v_all = jnp.concatenate([vx, vc], axis=1)
    nb = t // C_BLOCK
    qb = jnp.moveaxis(rope_2d(qx, rope).reshape(bsz, nb, C_BLOCK, C_HEADS, 2, C_HEAD_DIM), 1, 0)
    o_x = lax.map(lambda qblk: diff_attn(qblk, k_all, v_all, lam, scale), qb)
    o_x = jnp.moveaxis(o_x, 0, 1).reshape(bsz, t, C_HEADS, 2 * C_HEAD_DIM)

    def diff_out(o):
        return (rmsnorm(o, c_gain.reshape(C_HEADS, 2 * C_HEAD_DIM)) * (1.0 - lam_init)).reshape(
            o.shape[0], o.shape[1], C_V)

    hg = D_HEADS // D_GROUPS

    def ssd_inputs(p):
        b_, t_ = p[4].shape[:2]
        xbc = jax.nn.silu(dwconv(p[4], conv_w) + conv_b).astype(jnp.float32)
        xs, bm, cm = jnp.split(xbc, [D_INNER, D_INNER + D_GROUPS * D_STATE], axis=-1)
        xs = xs.reshape(b_, t_, D_GROUPS, hg, D_HEAD_DIM)
        bm = bm.reshape(b_, t_, D_GROUPS, D_STATE)
        cm = cm.reshape(b_, t_, D_GROUPS, D_STATE)
        dtr = p[5].astype(jnp.float32).reshape(b_, t_, 2, D_GROUPS, hg)
        dirs = []
        for d in range(2):
            dt = jax.nn.softplus(dtr[:, :, d] + dt_bias[d].astype(jnp.float32).reshape(D_GROUPS, hg))
            a = dt * (-jnp.exp(a_log[d].astype(jnp.float32))).reshape(D_GROUPS, hg)
            dirs.append((xs, dt, a, bm, cm))
        return xs, tuple(dirs)

    xs_c, dirs_c = ssd_inputs(pc)
    xs_x, dirs_x = ssd_inputs(px)
    zero = jnp.zeros((bsz, D_GROUPS, hg, D_HEAD_DIM, D_STATE), jnp.float32)
    ys_c, ys_x = bidir(ssd_chunked, dirs_c, dirs_x, zero, need_ctx)

    def ssd_out(y, xs, p):
        b_, t_ = p[3].shape[:2]
        y = y + skip.astype(jnp.float32).reshape(D_GROUPS, hg, 1) * xs
        z = jax.nn.silu(p[3].astype(jnp.float32))
        yz = y.reshape(b_, t_, D_GROUPS, hg * D_HEAD_DIM) * z.reshape(b_, t_, D_GROUPS, hg * D_HEAD_DIM)
        return rmsnorm(yz, d_gain.reshape(D_GROUPS, hg * D_HEAD_DIM)).reshape(b_, t_, D_INNER).astype(p[3].dtype)

    yx = jnp.concatenate([diff_out(o_x), ssd_out(ys_x, xs_x, px)], axis=-1) @ w_out
    yc = None
    if need_ctx:
        o_c = diff_attn(qc, kc, vc, lam, scale)
        yc = jnp.concatenate([diff_out(o_c), ssd_out(ys_c, xs_c, pc)], axis=-1) @ w_out
    return yc, yx


def conv_ffn(u, w_gate, w_up, conv_w, w_down):
    g = dwconv(u @ w_gate, conv_w)
    return (jax.nn.silu(g) * (u @ w_up)) @ w_down


def setup_inputs(seed: int = 0) -> dict:
    key = jax.random.key(seed)
    ks = jax.random.split(key, 32)
    f32 = jnp.float32
    D = D_MODEL
    ne, no = (DEPTH + 1) // 2, DEPTH // 2

    def nrm(i, shape, s):
        return jax.random.normal(ks[i], shape, f32) * s

    x = nrm(0, (BATCH, SEQ, D), 1.0)
    c = nrm(1, (BATCH, D), 1.0)
    ctx = nrm(2, (BATCH, CTX_LEN, D), 1.0)
    c_ctx = nrm(3, (D,), 1.0)
    mod_w = nrm(4, (DEPTH, D, 6 * D), 0.5 * D ** -0.5)
    mod_b = nrm(5, (DEPTH, 6 * D), 0.02)
    norm_g = 1.0 + nrm(6, (DEPTH, 4, D), 0.02)
    ffn_w_gate = nrm(7, (DEPTH, D, FFN_HIDDEN), D ** -0.5)
    ffn_w_up = nrm(8, (DEPTH, D, FFN_HIDDEN), D ** -0.5)
    ffn_conv = nrm(9, (DEPTH, FFN_CONV_W, FFN_HIDDEN), FFN_CONV_W ** -0.5)
    ffn_w_down = nrm(10, (DEPTH, FFN_HIDDEN, D), FFN_HIDDEN ** -0.5)
    ev_w_in = nrm(11, (ne, D, EVEN_IN), D ** -0.5)
    ev_w_out = nrm(12, (ne, MIX_WIDTH, D), MIX_WIDTH ** -0.5)
    a_sink = nrm(13, (ne, A_HEADS), 0.5)
    b_conv = nrm(14, (ne, SHORT_CONV_W, B_QK), SHORT_CONV_W ** -0.5)
    f_bias = jnp.broadcast_to(jnp.tile(jnp.linspace(3.0, 6.0, B_HEADS), 2), (ne, 2 * B_HEADS))
    b_gate_b = jnp.concatenate([nrm(15, (ne, 2 * B_HEADS), 0.1), f_bias + nrm(16, (ne, 2 * B_HEADS), 0.1)], axis=-1)
    b_norm_g = 1.0 + nrm(17, (ne, B_V), 0.02)
    od_w_in = nrm(18, (no, D, ODD_IN), D ** -0.5)
    od_w_out = nrm(19, (no, MIX_WIDTH, D), MIX_WIDTH ** -0.5)
    c_lambda = nrm(20, (no, 4, C_HEAD_DIM), 0.1)
    c_norm_g = 1.0 + nrm(21, (no, C_V), 0.02)
    d_conv = nrm(22, (no, SHORT_CONV_W, D_XBC), SHORT_CONV_W ** -0.5)
    d_conv_b = nrm(23, (no, D_XBC), 0.02)
    dt0 = jnp.exp(jax.random.uniform(ks[24], (no, 2, D_HEADS), f32, math.log(1e-3), math.log(1e-1)))
    d_dt_bias = dt0 + jnp.log(-jnp.expm1(-dt0))
    d_a_log = jnp.log(jax.random.uniform(ks[25], (no, 2, D_HEADS), f32, 1.0, 16.0))
    d_skip = 1.0 + nrm(26, (no, D_HEADS), 0.02)
    d_norm_g = 1.0 + nrm(27, (no, D_INNER), 0.02)
    return {'x': x, 'c': c, 'ctx': ctx, 'c_ctx': c_ctx, 'mod_w': mod_w, 'mod_b': mod_b, 'norm_g': norm_g,
            'ffn_w_gate': ffn_w_gate, 'ffn_w_up': ffn_w_up, 'ffn_conv': ffn_conv, 'ffn_w_down': ffn_w_down,
            'ev_w_in': ev_w_in, 'ev_w_out': ev_w_out, 'a_sink': a_sink, 'b_conv': b_conv, 'b_gate_b': b_gate_b,
            'b_norm_g': b_norm_g, 'od_w_in': od_w_in, 'od_w_out': od_w_out, 'c_lambda': c_lambda,
            'c_norm_g': c_norm_g, 'd_conv': d_conv, 'd_conv_b': d_conv_b, 'd_dt_bias': d_dt_bias,
            'd_a_log': d_a_log, 'd_skip': d_skip, 'd_norm_g': d_norm_g}


def reference(x, c, ctx, c_ctx, mod_w, mod_b, norm_g, ffn_w_gate, ffn_w_up, ffn_conv, ffn_w_down,
              ev_w_in, ev_w_out, a_sink, b_conv, b_gate_b, b_norm_g, od_w_in, od_w_out, c_lambda,
              c_norm_g, d_conv, d_conv_b, d_dt_bias, d_a_log, d_skip, d_norm_g):
    rows = x.shape[1] // GRID_W
    rope_a = axial_rope_tables(rows, A_HEAD_DIM)
    rope_c = axial_rope_tables(rows, C_HEAD_DIM)
    hx, hc = x, ctx
    for l in range(DEPTH):
        need_ctx = l < DEPTH - 1
        j = l // 2
        mx = jnp.split((jax.nn.silu(c) @ mod_w[l] + mod_b[l])[:, None, :], 6, axis=-1)
        mc = jnp.split(jax.nn.silu(c_ctx) @ mod_w[l] + mod_b[l], 6, axis=-1)
        g = norm_g[l]
        ux = modulate(rmsnorm(hx, g[0]), mx[0], mx[1])
        uc = modulate(rmsnorm(hc, g[0]), mc[0], mc[1])
        if l % 2 == 0:
            yc, yx = even_mixer(uc, ux, ev_w_in[j], ev_w_out[j], a_sink[j], b_conv[j], b_gate_b[j],
                                b_norm_g[j], rope_a, need_ctx)
        else:
            lam_init = 0.8 - 0.6 * math.exp(-0.3 * l)
            yc, yx = odd_mixer(uc, ux, od_w_in[j], od_w_out[j], c_lambda[j], c_norm_g[j], d_conv[j],
                               d_conv_b[j], d_dt_bias[j], d_a_log[j], d_skip[j], d_norm_g[j], rope_c,
                               lam_init, need_ctx)
        hx = hx + mx[2] * rmsnorm(yx, g[1])
        ux = modulate(rmsnorm(hx, g[2]), mx[3], mx[4])
        hx = hx + mx[5] * rmsnorm(conv_ffn(ux, ffn_w_gate[l], ffn_w_up[l], ffn_conv[l], ffn_w_down[l]), g[3])
        if need_ctx:
            hc = hc + mc[2] * rmsnorm(yc, g[1])
            uc = modulate(rmsnorm(hc, g[2]), mc[3], mc[4])
            hc = hc + mc[5] * rmsnorm(conv_ffn(uc, ffn_w_gate[l], ffn_w_up[l], ffn_conv[l], ffn_w_down[l]), g[3])
    return hx
```

```cpp
#include <hip/hip_runtime.h>
#include <hip/hip_cooperative_groups.h>
#include <cstdio>
namespace cg = cooperative_groups;

#define DI __device__ __forceinline__
#define LAS __attribute__((address_space(3)))
typedef unsigned short bf16_t;
typedef short bf16x8 __attribute__((ext_vector_type(8)));
typedef short s16x4 __attribute__((ext_vector_type(4)));
typedef float f32x4 __attribute__((ext_vector_type(4)));
typedef float f32x2 __attribute__((ext_vector_type(2)));
typedef float f32x16 __attribute__((ext_vector_type(16)));
typedef unsigned u32x4 __attribute__((ext_vector_type(4)));
typedef unsigned u32x2 __attribute__((ext_vector_type(2)));
typedef __bf16 bfv2 __attribute__((ext_vector_type(2)));

constexpr int D = 1024, NB = 8, T = 4096, CT = 256;
constexpr int ML = NB * T, MC = NB * CT, MT = ML + MC;
constexpr int NP0 = 2304, NP1 = 3072, FH = 2816;
constexpr float EPS = 1e-6f;
constexpr float LOG2E = 1.4426950408889634f;
constexpr float QSCALE = 0.125f * LOG2E;
constexpr int NTHR = 512;
constexpr int LDS_BYTES = 148480;
constexpr int LDS_TOTAL = LDS_BYTES + 256;

constexpr size_t al256(size_t x) { return (x + 255) & ~(size_t)255; }
constexpr size_t WS_WT_IN0 = 0;
constexpr size_t WS_WT_IN1 = WS_WT_IN0 + (size_t)NP0 * D * 2;
constexpr size_t WS_WT_OUT0 = WS_WT_IN1 + (size_t)NP1 * D * 2;
constexpr size_t WS_WT_OUT1 = WS_WT_OUT0 + (size_t)D * D * 2;
constexpr size_t WS_WT_GU0 = WS_WT_OUT1 + (size_t)D * D * 2;
constexpr size_t WS_WT_GU1 = WS_WT_GU0 + (size_t)2 * FH * D * 2;
constexpr size_t WS_WT_DN0 = WS_WT_GU1 + (size_t)2 * FH * D * 2;
constexpr size_t WS_WT_DN1 = WS_WT_DN0 + (size_t)D * FH * 2;
constexpr size_t WS_HC = WS_WT_DN1 + (size_t)D * FH * 2;
constexpr size_t WS_MODS = WS_HC + (size_t)MC * D * 4;
constexpr size_t WS_GATES = al256(WS_MODS + (size_t)2 * 9 * 6144 * 4);
constexpr size_t WS_SC = al256(WS_GATES + (size_t)MT * 16 * 4);
constexpr size_t WS_NS = al256(WS_SC + (size_t)4352 * 8 * 4);
constexpr size_t WS_BAR = al256(WS_NS + (size_t)4352 * 64 * 4);
constexpr size_t WS_ROPE = al256(WS_BAR + (size_t)4096 * 4);
constexpr size_t WS_UY = al256(WS_ROPE + 8192 + 4096);
constexpr size_t WS_BIG = al256(WS_UY + (size_t)MT * D * 2);
constexpr size_t BIG_P = 0;
constexpr size_t BIG_ST = (size_t)MT * NP1 * 2;
constexpr size_t BIG_CV = BIG_ST + (size_t)4352 * 8192 * 2;
constexpr size_t BIG_VT = BIG_CV + (size_t)MT * 1024 * 2;
constexpr size_t BIG_G = 0;
constexpr size_t BIG_U = (size_t)MT * FH * 2;
constexpr size_t WS_END = WS_BIG + 2 * (size_t)MT * FH * 2;
static_assert(BIG_VT + (size_t)32 * 128 * 4352 * 2 <= 2 * (size_t)MT * FH * 2, "mixer scratch fits");
static_assert(WS_END <= (size_t)536870912, "workspace");

struct Params {
    const float *x, *c, *ctx, *c_ctx, *mod_w, *mod_b, *norm_g, *ffn_w_gate, *ffn_w_up, *ffn_conv, *ffn_w_down,
        *ev_w_in, *ev_w_out, *a_sink, *b_conv, *b_gate_b, *b_norm_g, *od_w_in, *od_w_out, *c_lambda,
        *c_norm_g, *d_conv, *d_conv_b, *d_dt_bias, *d_a_log, *d_skip, *d_norm_g;
    float* out; unsigned char* ws; int ph_lo, ph_hi;
};

DI int tidx() { int t = threadIdx.x; asm volatile("" : "+v"(t)); return t; }
DI int bidx() { int t = blockIdx.x; asm volatile("" : "+s"(t)); return t; }
DI float bf2f(bf16_t b) { return __uint_as_float(((unsigned)b) << 16); }
DI unsigned pk2(float lo, float hi) { f32x2 v = {lo, hi}; bfv2 b = __builtin_convertvector(v, bfv2); return __builtin_bit_cast(unsigned, b); }
DI bf16_t f2bf(float f) { return (bf16_t)(pk2(f, 0.f) & 0xffffu); }
DI float lo16(unsigned u) { return __uint_as_float(u << 16); }
DI float hi16(unsigned u) { return __uint_as_float(u & 0xffff0000u); }
DI float silu_f(float v) { return v * __builtin_amdgcn_rcpf(1.f + __expf(-v)); }
DI float sigmoid_f(float v) { return __builtin_amdgcn_rcpf(1.f + __expf(-v)); }
DI float wave_sum(float v) {
#pragma unroll
    for (int o = 32; o >= 1; o >>= 1) v += __shfl_xor(v, o);
    return v;
}
DI float wave_scan_add(float v, int lane) {
#pragma unroll
    for (int o = 1; o < 64; o <<= 1) { const float t = __shfl_up(v, o); if (lane >= o) v += t; }
    return v;
}
DI float wave_scan_max(float v, int lane) {
#pragma unroll
    for (int o = 1; o < 64; o <<= 1) { const float t = __shfl_up(v, o); if (lane >= o) v = fmaxf(v, t); }
    return v;
}
DI float wave_max(float v) {
#pragma unroll
    for (int o = 32; o >= 1; o >>= 1) v = fmaxf(v, __shfl_xor(v, o));
    return v;
}
DI float xor32(float v, int h) {
    const unsigned u = __builtin_bit_cast(unsigned, v);
    const auto r = __builtin_amdgcn_permlane32_swap(u, u, false, false);
    return __builtin_bit_cast(float, h ? r[0] : r[1]);
}
DI int crow(int i, int h) { return (i & 3) + 8 * (i >> 2) + 4 * h; }
#define MFMA32(a, b, c) __builtin_amdgcn_mfma_f32_32x32x16_bf16((a), (b), (c), 0, 0, 0)
DI bf16x8 pack8(const f32x16& x, int s) {
    u32x4 p;
    p.x = pk2(x[8 * s + 0], x[8 * s + 1]); p.y = pk2(x[8 * s + 2], x[8 * s + 3]);
    p.z = pk2(x[8 * s + 4], x[8 * s + 5]); p.w = pk2(x[8 * s + 6], x[8 * s + 7]);
    return __builtin_bit_cast(bf16x8, p);
}
DI bf16x8 ld_tr2(const bf16_t* p) {
    s16x4 lo = *(const s16x4*)p, hi = *(const s16x4*)(p + 8);
    return __builtin_shufflevector(lo, hi, 0, 1, 2, 3, 4, 5, 6, 7);
}
DI f32x16 zero16() { f32x16 z; for (int i = 0; i < 16; ++i) z[i] = 0.f; return z; }

namespace pg8 {
constexpr int BM = 256, BK = 64, HALF = 128, HTB = HALF * BK * 2, STAGE_BYTES = 8 * HTB, NXCD = 8, WGM = 8;
DI int lds_byte(int r, int c) { const int st = (r >> 4) * 2 + (c >> 5), rr = r & 15, cc = c & 31, ob = rr * 64 + cc * 2; return st * 1024 + (ob ^ (((ob >> 9) & 1) << 5)); }
DI void stage_rc(int b, int& R, int& C) { const int st = b / 1024, sb = b % 1024, swz = sb ^ (((sb >> 9) & 1) << 5); R = (st >> 1) * 16 + swz / 64; C = (st & 1) * 32 + (swz % 64) / 2; }
DI int perm32(int rho) { const int n = rho >> 4, i = rho & 15; return 8 * (i >> 2) + 4 * n + (i & 3); }
struct Unit { int pm, pn; };
struct Gemm { const bf16_t* A; const bf16_t* Bt; int M, N, K; int conv; };
struct StaticOrder {
    int nM, nN, nwg, G, c;
    DI void init(int M, int N, int G_, int c_) { nM = M / BM; nN = N / BM; nwg = nM * nN; G = G_; c = c_; }
    DI void init_tiles(int nM_, int nN_, int G_, int c_) { nM = nM_; nN = nN_; nwg = nM * nN; G = G_; c = c_; }
    DI bool next(int i, Unit& u) const {
        const long L = (long)i * G + c; if (L >= nwg) return false;
        int wgid = (int)L; { const int q = nwg / NXCD, r = nwg % NXCD, xcd = wgid % NXCD, off = wgid / NXCD; wgid = (xcd < r ? xcd * (q + 1) : r * (q + 1) + (xcd - r) * q) + off; }
        const int nig = WGM * nN, gid = wgid / nig, fm = gid * WGM, gsz = (nM - fm) < WGM ? (nM - fm) : WGM;
        u.pm = fm + ((wgid % nig) % gsz); u.pn = (wgid % nig) / gsz; return true;
    }
};
struct EpiBf {
    bf16_t* O; int ldc; int split_cols; size_t split_stride;
    DI void operator()(const f32x4 (&acc)[2][2][4][2], const Unit& u, int wr, int wc, int fr, int fq) const {
        const int row0 = u.pm * BM + wr * 64 + fr; int colt = u.pn * BM; bf16_t* base = O;
        if (split_cols) { const int t = colt / split_cols; base += (size_t)t * split_stride; colt -= t * split_cols; }
        const int col0 = colt + wc * 32 + 8 * fq;
#pragma unroll
        for (int ai = 0; ai < 2; ++ai)
#pragma unroll
            for (int m = 0; m < 4; ++m) { bf16_t* rowp = base + (size_t)(row0 + ai * HALF + m * 16) * ldc + col0;
#pragma unroll
                for (int bj = 0; bj < 2; ++bj) { const f32x4 v0 = acc[ai][bj][m][0], v1 = acc[ai][bj][m][1];
                    u32x4 w; w.x = pk2(v0[0], v0[1]); w.y = pk2(v0[2], v0[3]); w.z = pk2(v1[0], v1[1]); w.w = pk2(v1[2], v1[3]);
                    *(u32x4*)(rowp + bj * HALF) = w; } }
    }
};
DI float dpp_ror1(float v) { return __builtin_bit_cast(float, __builtin_amdgcn_mov_dpp(__builtin_bit_cast(int, v), 0x121, 0xf, 0xf, false)); }
DI float dpp_ror15(float v) { return __builtin_bit_cast(float, __builtin_amdgcn_mov_dpp(__builtin_bit_cast(int, v), 0x12f, 0xf, 0xf, false)); }
DI float nb_up1(float cur, float prv) { return __builtin_bit_cast(float, __builtin_amdgcn_update_dpp(__builtin_bit_cast(int, dpp_ror1(prv)), __builtin_bit_cast(int, cur), 0x111, 0xf, 0xf, false)); }
DI float nb_dn1(float cur, float nxt) { return __builtin_bit_cast(float, __builtin_amdgcn_update_dpp(__builtin_bit_cast(int, dpp_ror15(nxt)), __builtin_bit_cast(int, cur), 0x101, 0xf, 0xf, false)); }
struct EpiAct {
    bf16_t* H; const bf16_t* cw; int nrows;
    DI void operator()(const f32x4 (&acc)[2][2][4][2], const Unit& u, int wr, int wc, int fr, int fq) const {
        const int gcol = u.pn * 128 + wc * 32 + 8 * fq;
        f32x4 w0[2], w1[2], w2[2];
#pragma unroll
        for (int n = 0; n < 2; ++n) { const u32x2 t0 = *(const u32x2*)(cw + gcol + 4 * n), t1 = *(const u32x2*)(cw + FH + gcol + 4 * n), t2 = *(const u32x2*)(cw + 2 * FH + gcol + 4 * n);
            w0[n] = (f32x4){lo16(t0.x), hi16(t0.x), lo16(t0.y), hi16(t0.y)}; w1[n] = (f32x4){lo16(t1.x), hi16(t1.x), lo16(t1.y), hi16(t1.y)}; w2[n] = (f32x4){lo16(t2.x), hi16(t2.x), lo16(t2.y), hi16(t2.y)}; }
#pragma unroll
        for (int ai = 0; ai < 2; ++ai)
#pragma unroll
            for (int m = 0; m < 4; ++m) {
                const int inb = 16 * m + fr, row = u.pm * 248 + (ai * 2 + wr) * 62 + inb - 1;
                int t, len; if (row < ML) { t = row & (T - 1); len = T; } else { t = (row - ML) & (CT - 1); len = CT; }
                const bool has_up = t > 0, has_dn = t < len - 1, st = inb >= 1 && inb <= 62 && row < nrows;
                f32x4 hv[2];
#pragma unroll
                for (int n = 0; n < 2; ++n) { const f32x4 g = acc[ai][0][m][n], gp = acc[ai][0][m > 0 ? m - 1 : 0][n], gn = acc[ai][0][m < 3 ? m + 1 : 3][n];
                    f32x4 wu, wd;
#pragma unroll
                    for (int j = 0; j < 4; ++j) { wu[j] = has_up ? w0[n][j] : 0.f; wd[j] = has_dn ? w2[n][j] : 0.f; }
#pragma unroll
                    for (int j = 0; j < 4; ++j) { const float up = nb_up1(g[j], gp[j]), dn = nb_dn1(g[j], gn[j]);
                        const float cv = fmaf(wu[j], up, fmaf(wd[j], dn, w1[n][j] * g[j]));
                        hv[n][j] = silu_f(cv) * acc[ai][1][m][n][j]; } }
                if (st) { u32x4 w; w.x = pk2(hv[0][0], hv[0][1]); w.y = pk2(hv[0][2], hv[0][3]); w.z = pk2(hv[1][0], hv[1][1]); w.w = pk2(hv[1][2], hv[1][3]);
                    *(u32x4*)(H + (size_t)row * FH + gcol) = w; }
            }
    }
};
DI float nb_up2(float cur, float prv) { const int o = __builtin_amdgcn_mov_dpp(__builtin_bit_cast(int, prv), 0x122, 0xf, 0xf, false);
    return __builtin_bit_cast(float, __builtin_amdgcn_update_dpp(o, __builtin_bit_cast(int, cur), 0x112, 0xf, 0xf, false)); }
DI float nb_dn2(float cur, float nxt) { const int o = __builtin_amdgcn_mov_dpp(__builtin_bit_cast(int, nxt), 0x12e, 0xf, 0xf, false);
    return __builtin_bit_cast(float, __builtin_amdgcn_update_dpp(o, __builtin_bit_cast(int, cur), 0x102, 0xf, 0xf, false)); }
struct EpiConv5 {
    bf16_t* P; bf16_t* X; const bf16_t* cw; const bf16_t* cb; int nrows;
    DI void operator()(const f32x4 (&acc)[2][2][4][2], const Unit& u, int wr, int wc, int fr, int fq) const { half<0>(acc, u, wr, wc, fr, fq); half<1>(acc, u, wr, wc, fr, fq); }
    template <int AI> DI void half(const f32x4 (&acc)[2][2][4][2], const Unit& u, int wr_, int wc_, int fr_, int fq_) const {
        constexpr int ai = AI;
        const int tid_ = tidx(), wid_ = __builtin_amdgcn_readfirstlane(tid_ >> 6), wr = wid_ >> 2, wc = wid_ & 3, fr = tid_ & 15, fq = (tid_ & 63) >> 4;
        if (u.pn < 8) {
            const int col0 = u.pn * 256 + wc * 32 + 8 * fq;
#pragma unroll
            for (int m = 0; m < 4; ++m) { const int inb = 16 * m + fr, row = u.pm * 240 + (ai * 2 + wr) * 60 + inb - 2;
                if (inb >= 2 && inb <= 61 && row < nrows) {
#pragma unroll
                    for (int bj = 0; bj < 2; ++bj) { const f32x4 v0 = acc[ai][bj][m][0], v1 = acc[ai][bj][m][1];
                        u32x4 w; w.x = pk2(v0[0], v0[1]); w.y = pk2(v0[2], v0[3]); w.z = pk2(v1[0], v1[1]); w.w = pk2(v1[2], v1[3]);
                        *(u32x4*)(P + (size_t)row * NP1 + col0 + bj * HALF) = w; } } }
        } else {
#pragma unroll
            for (int bj = 0; bj < 2; ++bj)
#pragma unroll
                for (int n = 0; n < 2; ++n) {
                    const int gcol = (u.pn - 8) * 256 + bj * HALF + wc * 32 + 8 * fq + 4 * n;
                    f32x4 w[5];
                    const u32x2 tb = *(const u32x2*)(cb + gcol);
                    const f32x4 bs = (f32x4){lo16(tb.x), hi16(tb.x), lo16(tb.y), hi16(tb.y)};
#pragma unroll
                    for (int j = 0; j < 5; ++j) { const u32x2 tw = *(const u32x2*)(cw + j * 1024 + gcol); w[j] = (f32x4){lo16(tw.x), hi16(tw.x), lo16(tw.y), hi16(tw.y)}; }
#pragma unroll
                    for (int m = 0; m < 4; ++m) {
                        const int inb = 16 * m + fr, row = u.pm * 240 + (ai * 2 + wr) * 60 + inb - 2;
                        int t, len; if (row < ML) { t = row & (T - 1); len = T; } else { t = (row - ML) & (CT - 1); len = CT; }
                        const bool st = inb >= 2 && inb <= 61 && row < nrows;
                        const f32x4 g = acc[ai][bj][m][n], gp = acc[ai][bj][m > 0 ? m - 1 : 0][n], gn = acc[ai][bj][m < 3 ? m + 1 : 3][n];
                        float hv[4];
                        const bool m0 = t >= 2, m1 = t >= 1, m3 = t <= len - 2, m4 = t <= len - 3;
#pragma unroll
                        for (int j = 0; j < 4; ++j) {
                            const float up1 = nb_up1(g[j], gp[j]), up2 = nb_up2(g[j], gp[j]), dn1 = nb_dn1(g[j], gn[j]), dn2 = nb_dn2(g[j], gn[j]);
                            float cv = fmaf(w[2][j], g[j], bs[j]);
                            cv = fmaf(m1 ? w[1][j] : 0.f, up1, cv); cv = fmaf(m0 ? w[0][j] : 0.f, up2, cv);
                            cv = fmaf(m3 ? w[3][j] : 0.f, dn1, cv); cv = fmaf(m4 ? w[4][j] : 0.f, dn2, cv);
                            hv[j] = silu_f(cv); }
                        if (st) { u32x2 wv; wv.x = pk2(hv[0], hv[1]); wv.y = pk2(hv[2], hv[3]); *(u32x2*)(X + (size_t)row * 1024 + gcol) = wv; }
                        __builtin_amdgcn_sched_barrier(0);
                    }
                    __builtin_amdgcn_sched_barrier(0);
                }
        }
    }
};
template <class Epi, class Sched>
DI void gemm_phase(LAS unsigned char* lds, const Gemm g, const Sched& S, const Epi& E) {
    const int tid = tidx(), wid = __builtin_amdgcn_readfirstlane(tid >> 6), lane = tid & 63, wr = wid >> 2, wc = wid & 3, fr = lane & 15, fq = lane >> 4;
    const int K = g.K, nt = K / BK;
    unsigned voffA[2], voffB[2];
#pragma unroll
    for (int i = 0; i < 2; ++i) { int R, C; stage_rc(tid * 16 + i * 8192, R, C); const int Rb = (R & ~31) + perm32(R & 31);
        const int Ra = g.conv ? ((R >> 6) * g.conv + (R & 63)) : R;
        voffA[i] = (unsigned)(Ra * K + C) * 2u; voffB[i] = (unsigned)(Rb * K + C) * 2u; }
    const size_t kstep = (size_t)(BK * 2);
    const size_t hstep = (size_t)HALF * K * 2;
    const size_t tstep = 2 * hstep;
    const size_t hstepA = g.conv ? (size_t)(2 * g.conv) * K * 2 : hstep, tstepA = 2 * hstepA;
    const unsigned ldsw = (unsigned)wid * 1024u;
    const int aoff = lds_byte(wr * 64 + fr, fq * 8), boff = lds_byte(wc * 32 + fr, fq * 8);
#define PG8_SA(b, h) (((b) * 2 + (h)) * HTB)
#define PG8_SB(b, h) ((4 + (b) * 2 + (h)) * HTB)
#define PG8_STAGE(bufoff, gbase, voff) do { _Pragma("unroll") for (int _i = 0; _i < 2; ++_i) \
        __builtin_amdgcn_global_load_lds((const unsigned*)((const char*)(gbase) + (voff)[_i]), (LAS unsigned*)(lds + (bufoff) + ldsw + _i * 8192), 16, 0, 0); } while (0)
#define PG8_LDA(dst, b, h) do { _Pragma("unroll") for (int m = 0; m < 4; ++m) _Pragma("unroll") for (int k = 0; k < 2; ++k) dst[m][k] = *(const LAS bf16x8*)(lds + PG8_SA(b, h) + aoff + m * 2048 + k * 1024); } while (0)
#define PG8_LDB(dst, b, h) do { _Pragma("unroll") for (int n = 0; n < 2; ++n) _Pragma("unroll") for (int k = 0; k < 2; ++k) dst[n][k] = *(const LAS bf16x8*)(lds + PG8_SB(b, h) + boff + n * 2048 + k * 1024); } while (0)
#define PG8_MMA(ai, bj, At, Bt) do { __builtin_amdgcn_s_setprio(1); _Pragma("unroll") for (int m = 0; m < 4; ++m) _Pragma("unroll") for (int n = 0; n < 2; ++n) _Pragma("unroll") for (int k = 0; k < 2; ++k) \
        acc[ai][bj][m][n] = __builtin_amdgcn_mfma_f32_16x16x32_bf16(Bt[n][k], At[m][k], acc[ai][bj][m][n], 0, 0, 0); __builtin_amdgcn_s_setprio(0); } while (0)
#define PG8_WAIT_V(n) asm volatile("s_waitcnt vmcnt(" #n ")" ::: "memory")
#define PG8_WAIT_L(n) asm volatile("s_waitcnt lgkmcnt(" #n ")" ::: "memory")
#define PG8_BAR __builtin_amdgcn_s_barrier()
#define PG8_SCHED __builtin_amdgcn_sched_barrier(0)
    Unit cur, nxt; int ui = 0;
    if (!S.next(0, cur)) return;
    f32x4 acc[2][2][4][2];
#pragma unroll
    for (int a = 0; a < 2; ++a)
#pragma unroll
        for (int b = 0; b < 2; ++b)
#pragma unroll
            for (int m = 0; m < 4; ++m)
#pragma unroll
                for (int n = 0; n < 2; ++n) acc[a][b][m][n] = (f32x4){0.f, 0.f, 0.f, 0.f};
    bf16x8 At[4][2], B0[2][2], B1[2][2];
    const char* cA = (const char*)g.A + (size_t)cur.pm * tstepA; const char* cB = (const char*)g.Bt + (size_t)cur.pn * tstep;
    PG8_STAGE(PG8_SB(0, 0), cB, voffB); PG8_STAGE(PG8_SA(0, 0), cA, voffA); PG8_STAGE(PG8_SB(0, 1), cB + hstep, voffB); PG8_STAGE(PG8_SA(0, 1), cA + hstepA, voffA);
    if (wr == 1) PG8_BAR;
    PG8_WAIT_V(4); PG8_BAR;
    PG8_STAGE(PG8_SB(1, 0), cB + kstep, voffB); PG8_STAGE(PG8_SA(1, 0), cA + kstep, voffA); PG8_STAGE(PG8_SB(1, 1), cB + hstep + kstep, voffB);
    PG8_WAIT_V(6); PG8_BAR;
    for (;;) {
        const bool has_next = S.next(ui + 1, nxt);
        const char* nA = has_next ? (const char*)g.A + (size_t)nxt.pm * tstepA : cA; const char* nB = has_next ? (const char*)g.Bt + (size_t)nxt.pn * tstep : cB;
        for (int t = 0; t < nt; t += 2) {
            const bool last = (t == nt - 2);
            const char* a1 = cA + (size_t)(t + 1) * kstep;
            const char* a2 = last ? nA : cA + (size_t)(t + 2) * kstep; const char* b2 = last ? nB : cB + (size_t)(t + 2) * kstep;
            const char* a3 = a2 + kstep; const char* b3 = b2 + kstep;
            PG8_LDB(B0, 0, 0); PG8_SCHED; PG8_LDA(At, 0, 0); PG8_STAGE(PG8_SA(1, 1), a1 + hstepA, voffA);
            PG8_WAIT_L(8); PG8_BAR; PG8_WAIT_L(0); PG8_MMA(0, 0, At, B0); PG8_BAR; PG8_SCHED;
            PG8_LDB(B1, 0, 1); PG8_STAGE(PG8_SB(0, 0), b2, voffB);
            PG8_BAR; PG8_WAIT_L(0); PG8_MMA(0, 1, At, B1); PG8_BAR;
            PG8_LDA(At, 0, 1); PG8_STAGE(PG8_SA(0, 0), a2, voffA);
            PG8_BAR; PG8_WAIT_L(0); PG8_MMA(1, 0, At, B0); PG8_BAR; PG8_SCHED;
            PG8_STAGE(PG8_SB(0, 1), b2 + hstep, voffB);
            PG8_WAIT_V(6); PG8_BAR; PG8_MMA(1, 1, At, B1); PG8_BAR;
            PG8_LDB(B0, 1, 0); PG8_SCHED; PG8_LDA(At, 1, 0); PG8_STAGE(PG8_SA(0, 1), a2 + hstepA, voffA);
            PG8_WAIT_L(8); PG8_BAR; PG8_WAIT_L(0); PG8_MMA(0, 0, At, B0); PG8_BAR; PG8_SCHED;
            PG8_LDB(B1, 1, 1); PG8_STAGE(PG8_SB(1, 0), b3, voffB);
            PG8_BAR; PG8_WAIT_L(0); PG8_MMA(0, 1, At, B1); PG8_BAR;
            PG8_LDA(At, 1, 1); PG8_STAGE(PG8_SA(1, 0), a3, voffA);
            PG8_BAR; PG8_WAIT_L(0); PG8_MMA(1, 0, At, B0); PG8_BAR; PG8_SCHED;
            PG8_STAGE(PG8_SB(1, 1), b3 + hstep, voffB);
            PG8_WAIT_V(6); PG8_BAR; PG8_MMA(1, 1, At, B1); PG8_BAR;
        }
        E(acc, cur, wr, wc, fr, fq);
        if (!has_next) break;
#pragma unroll
        for (int a = 0; a < 2; ++a)
#pragma unroll
            for (int b = 0; b < 2; ++b)
#pragma unroll
                for (int m = 0; m < 4; ++m)
#pragma unroll
                    for (int n = 0; n < 2; ++n) acc[a][b][m][n] = (f32x4){0.f, 0.f, 0.f, 0.f};
        cur = nxt; cA = nA; cB = nB; ++ui;
    }
    PG8_WAIT_V(0);
    if (wr == 0) PG8_BAR;
    PG8_BAR;
#undef PG8_SA
#undef PG8_SB
#undef PG8_STAGE
#undef PG8_LDA
#undef PG8_LDB
#undef PG8_MMA
#undef PG8_WAIT_V
#undef PG8_WAIT_L
#undef PG8_BAR
#undef PG8_SCHED
}
}

DI void run_gemm(unsigned char* lds, const bf16_t* A, const bf16_t* Bt, int M, int N, int K, bf16_t* O, int ldc, int split_cols, size_t split_stride, int G = 0, int c = 0) {
    asm volatile("" : "+s"(M), "+s"(N), "+s"(K));
    if (G == 0) { G = (int)gridDim.x; c = (int)bidx(); }
    pg8::Gemm g{A, Bt, M, N, K, 0}; pg8::StaticOrder S; S.init(M, N, G, c);
    pg8::EpiBf E{O, ldc, split_cols, split_stride};
    pg8::gemm_phase<pg8::EpiBf, pg8::StaticOrder>((LAS unsigned char*)lds, g, S, E);
    __syncthreads();
}

DI void run_gemm_act(unsigned char* lds, const bf16_t* U, const bf16_t* Bt, int nrows, bf16_t* H, const float* cw) {
    int K = D, nM = (nrows + 247) / 248, nN = FH / 128;
    asm volatile("" : "+s"(K), "+s"(nM), "+s"(nN));
    pg8::Gemm g{U - D, Bt, nrows, 2 * FH, K, 62}; pg8::StaticOrder S; S.init_tiles(nM, nN, (int)gridDim.x, bidx());
    bf16_t* taps = (bf16_t*)(lds + pg8::STAGE_BYTES);
    for (int i = tidx(); i < 3 * FH; i += NTHR) taps[i] = f2bf(cw[i]);
    __syncthreads();
    pg8::EpiAct E{H, taps, nrows};
    pg8::gemm_phase<pg8::EpiAct, pg8::StaticOrder>((LAS unsigned char*)lds, g, S, E);
    __syncthreads();
}

DI void run_gemm_in1(unsigned char* lds, const bf16_t* U, const bf16_t* Bt, bf16_t* P, bf16_t* X, const float* cw, const float* cb) {
    int K = D, nM = (MT + 239) / 240, nN = NP1 / 256;
    asm volatile("" : "+s"(K), "+s"(nM), "+s"(nN));
    pg8::Gemm g{U - 2 * D, Bt, MT, NP1, K, 60}; pg8::StaticOrder S; S.init_tiles(nM, nN, (int)gridDim.x, bidx());
    bf16_t* taps = (bf16_t*)(lds + pg8::STAGE_BYTES);
    for (int i = tidx(); i < 6 * 1024; i += NTHR) taps[i] = f2bf(i < 5120 ? cw[i] : cb[i - 5120]);
    __syncthreads();
    pg8::EpiConv5 E{P, X, taps, taps + 5120, MT};
    pg8::gemm_phase<pg8::EpiConv5, pg8::StaticOrder>((LAS unsigned char*)lds, g, S, E);
    __syncthreads();
}

struct TileJob { const float* src; bf16_t* dst; int ld, K, ilv, nt, kt; };
DI TileJob tile_job(const Params& p, int ti) {
    const float* src; bf16_t* dst; int ld, ncols, K, ilv = 0;
    if (ti < 576) { src = p.ev_w_in; dst = (bf16_t*)(p.ws + WS_WT_IN0); ld = 2320; ncols = NP0; K = D; }
    else if ((ti -= 576) < 768) { src = p.od_w_in; dst = (bf16_t*)(p.ws + WS_WT_IN1); ld = 3088; ncols = NP1; K = D; }
    else if ((ti -= 768) < 256) { src = p.ev_w_out; dst = (bf16_t*)(p.ws + WS_WT_OUT0); ld = D; ncols = D; K = D; }
    else if ((ti -= 256) < 256) { src = p.od_w_out; dst = (bf16_t*)(p.ws + WS_WT_OUT1); ld = D; ncols = D; K = D; }
    else if ((ti -= 256) < 704) { src = p.ffn_w_gate; dst = (bf16_t*)(p.ws + WS_WT_GU0); ld = FH; ncols = FH; K = D; ilv = 1; }
    else if ((ti -= 704) < 704) { src = p.ffn_w_up; dst = (bf16_t*)(p.ws + WS_WT_GU0); ld = FH; ncols = FH; K = D; ilv = 2; }
    else if ((ti -= 704) < 704) { src = p.ffn_w_gate + (size_t)D * FH; dst = (bf16_t*)(p.ws + WS_WT_GU1); ld = FH; ncols = FH; K = D; ilv = 1; }
    else if ((ti -= 704) < 704) { src = p.ffn_w_up + (size_t)D * FH; dst = (bf16_t*)(p.ws + WS_WT_GU1); ld = FH; ncols = FH; K = D; ilv = 2; }
    else if ((ti -= 704) < 704) { src = p.ffn_w_down; dst = (bf16_t*)(p.ws + WS_WT_DN0); ld = D; ncols = D; K = FH; }
    else { ti -= 704; src = p.ffn_w_down + (size_t)FH * D; dst = (bf16_t*)(p.ws + WS_WT_DN1); ld = D; ncols = D; K = FH; }
    const int ntn = ncols / 64;
    return TileJob{src, dst, ld, K, ilv, ti % ntn, ti / ntn};
}
DI void phase_prep(const Params& p, unsigned char* lds) {
    const int tid = tidx();
    if (bidx() == (int)gridDim.x - 1) { float* tab = (float*)(p.ws + WS_ROPE);
        for (int i = tid; i < 1024; i += NTHR) { const float inv = expf(-(float)(i & 15) * (9.210340371976184f / 16.f)); float sn, cs; sincosf((float)(i >> 4) * inv, &sn, &cs); tab[i] = cs; tab[1024 + i] = sn; } }
    float* sc = (float*)lds;
    float* tile = (float*)(lds + 40960);
    float* mods = (float*)(p.ws + WS_MODS);
    constexpr int NTILE = 6080;
    for (int item = bidx(); item < 192; item += gridDim.x) {
        if (item < 192) {
            const int l = item / 96, nc = item % 96, wv = tid >> 6, ln = tid & 63;
            for (int i = tid; i < 9 * 1024; i += NTHR) { const float v = (i < 8192) ? p.c[i] : p.c_ctx[i - 8192]; sc[i] = v / (1.f + expf(-v)); }
            __syncthreads();
            const int n = nc * 64 + ln;
            float acc[9];
#pragma unroll
            for (int i = 0; i < 9; ++i) acc[i] = 0.f;
            const float* w = p.mod_w + ((size_t)l * 1024 + wv * 128) * 6144 + n;
#pragma unroll 8
            for (int k = 0; k < 128; ++k) { const float wvv = w[(size_t)k * 6144];
#pragma unroll
                for (int i = 0; i < 9; ++i) acc[i] += sc[i * 1024 + wv * 128 + k] * wvv; }
            float* red = tile;
#pragma unroll
            for (int i = 0; i < 9; ++i) red[(wv * 9 + i) * 64 + ln] = acc[i];
            __syncthreads();
            for (int o = tid; o < 9 * 64; o += NTHR) { const int i = o >> 6, c = o & 63; float sum = p.mod_b[l * 6144 + nc * 64 + c];
#pragma unroll
                for (int q = 0; q < 8; ++q) sum += red[(q * 9 + i) * 64 + c];
                mods[(size_t)(l * 9 + i) * 6144 + nc * 64 + c] = sum; }
            __syncthreads();
        }
    }
    {
        const int G = (int)gridDim.x, b0 = bidx();
        const int lr = tid >> 4, lc = (tid & 15) * 4, sn = tid >> 3, sk = (tid & 7) * 8;
        f32x4 cur[2], nxt[2]; TileJob jc, jn;
        int ti = b0;
        if (ti < NTILE) { jc = tile_job(p, ti);
#pragma unroll
            for (int i = 0; i < 2; ++i) cur[i] = *(const f32x4*)(jc.src + (size_t)(jc.kt * 64 + lr + 32 * i) * jc.ld + jc.nt * 64 + lc); }
        for (; ti < NTILE; ti += G) {
            const bool more = ti + G < NTILE;
            if (more) { jn = tile_job(p, ti + G);
#pragma unroll
                for (int i = 0; i < 2; ++i) nxt[i] = *(const f32x4*)(jn.src + (size_t)(jn.kt * 64 + lr + 32 * i) * jn.ld + jn.nt * 64 + lc); }
#pragma unroll
            for (int i = 0; i < 2; ++i) { float* tp = tile + (lr + 32 * i) * 65 + lc; tp[0] = cur[i][0]; tp[1] = cur[i][1]; tp[2] = cur[i][2]; tp[3] = cur[i][3]; }
            __syncthreads();
            { const int n = jc.nt * 64 + sn, nr = jc.ilv ? ((n >> 7) << 8) + (n & 127) + (jc.ilv == 2 ? 128 : 0) : n;
              u32x4 w; w.x = pk2(tile[(sk + 0) * 65 + sn], tile[(sk + 1) * 65 + sn]); w.y = pk2(tile[(sk + 2) * 65 + sn], tile[(sk + 3) * 65 + sn]);
              w.z = pk2(tile[(sk + 4) * 65 + sn], tile[(sk + 5) * 65 + sn]); w.w = pk2(tile[(sk + 6) * 65 + sn], tile[(sk + 7) * 65 + sn]);
              *(u32x4*)(jc.dst + (size_t)nr * jc.K + jc.kt * 64 + sk) = w; }
            __syncthreads();
            if (more) { jc = jn; cur[0] = nxt[0]; cur[1] = nxt[1]; }
        }
    }
}

struct RNArgs {
    const float* hin_lat; const float* hin_ctx; const bf16_t* yo; const float* gy; const float* gatev;
    float* hout_lat; float* hout_ctx;
    const float* gu; const float* shiftv; const float* scalev; bf16_t* u;
    const float* gw; int gw_ld; float* gates; int nrows; int row_begin;
};
#define RN_STEP(N, BIT) { const bool hi_ = (lane & (BIT)) != 0; _Pragma("unroll") for (int j = 0; j < (N); ++j) { \
        const float keep_ = hi_ ? acc[j + (N)] : acc[j], send_ = hi_ ? acc[j] : acc[j + (N)]; acc[j] = keep_ + __shfl_xor(send_, (BIT)); } }
template <int NR, bool SETUP>
DI void phase_rownorm_t(const RNArgs& a, unsigned char* lds, int blk = -1, int nblk = 0) {
    if (blk < 0) { blk = bidx(); nblk = (int)gridDim.x; }
    const int lane = tidx() & 63, wave = tidx() >> 6;
    const int ngroups = a.nrows / NR;
    float* Lgg = (float*)lds; float* Lgs = Lgg + 9216; float* Lsh = Lgs + 9216;
    float* gwT = (float*)lds;
    float* Lgy = gwT + 16384; float* Lgu = Lgy + 1024;
    if (SETUP) {
        if (a.gw) for (int idx = tidx(); idx < 16384; idx += NTHR) { const int k = idx >> 4, j = idx & 15; gwT[j * 1024 + k] = a.gw[(size_t)k * a.gw_ld + j]; }
        for (int i = tidx(); i < 1024; i += NTHR) { Lgy[i] = a.yo ? a.gy[i] : 0.f; Lgu[i] = a.u ? a.gu[i] : 0.f; }
        __syncthreads();
    }
    for (int grp = blk * 8 + wave; grp < ngroups; grp += nblk * 8) {
        const int row0 = a.row_begin + grp * NR;
        const int bi = row0 < ML ? (row0 >> 12) : 8;
        const float* hin = row0 < ML ? a.hin_lat + (size_t)row0 * D : a.hin_ctx + (size_t)(row0 - ML) * D;
        f32x4 v[NR][4];
#pragma unroll
        for (int rr = 0; rr < NR; ++rr)
#pragma unroll
            for (int i = 0; i < 4; ++i) v[rr][i] = __builtin_nontemporal_load((const f32x4*)(hin + (size_t)rr * D + i * 256 + lane * 4));
        if (a.yo) {
            u32x2 yw[NR][4]; float rstd[NR];
#pragma unroll
            for (int rr = 0; rr < NR; ++rr)
#pragma unroll
                for (int i = 0; i < 4; ++i) yw[rr][i] = *(const u32x2*)(a.yo + (size_t)(row0 + rr) * D + i * 256 + lane * 4);
#pragma unroll
            for (int rr = 0; rr < NR; ++rr) { float ss = 0.f;
#pragma unroll
                for (int i = 0; i < 4; ++i) { const float y0 = lo16(yw[rr][i].x), y1 = hi16(yw[rr][i].x), y2 = lo16(yw[rr][i].y), y3 = hi16(yw[rr][i].y); ss += y0 * y0 + y1 * y1 + y2 * y2 + y3 * y3; }
                rstd[rr] = ss; }
#pragma unroll
            for (int rr = 0; rr < NR; ++rr) rstd[rr] = rsqrtf(wave_sum(rstd[rr]) * (1.f / D) + EPS);
            __builtin_amdgcn_sched_barrier(0);
            float* hout = row0 < ML ? a.hout_lat + (size_t)row0 * D : a.hout_ctx + (size_t)(row0 - ML) * D;
#pragma unroll
            for (int i = 0; i < 4; ++i) { const int c = i * 256 + lane * 4;
                const f32x4 gg = *(const f32x4*)(Lgy + c) * *(const f32x4*)(a.gatev + (size_t)bi * 6144 + c);
#pragma unroll
                for (int rr = 0; rr < NR; ++rr) { const f32x4 y = (f32x4){lo16(yw[rr][i].x), hi16(yw[rr][i].x), lo16(yw[rr][i].y), hi16(yw[rr][i].y)};
                    v[rr][i] = v[rr][i] + gg * (y * rstd[rr]);
                    __builtin_nontemporal_store(v[rr][i], (f32x4*)(hout + (size_t)rr * D + c)); } }
        }
        if (a.u) {
            float rstd[NR];
#pragma unroll
            for (int rr = 0; rr < NR; ++rr) { float ss = 0.f;
#pragma unroll
                for (int i = 0; i < 4; ++i) ss += v[rr][i][0] * v[rr][i][0] + v[rr][i][1] * v[rr][i][1] + v[rr][i][2] * v[rr][i][2] + v[rr][i][3] * v[rr][i][3];
                rstd[rr] = ss; }
#pragma unroll
            for (int rr = 0; rr < NR; ++rr) rstd[rr] = rsqrtf(wave_sum(rstd[rr]) * (1.f / D) + EPS);
            __builtin_amdgcn_sched_barrier(0);
#pragma unroll
            for (int i = 0; i < 4; ++i) { const int c = i * 256 + lane * 4;
                const f32x4 gs = *(const f32x4*)(Lgu + c) * (*(const f32x4*)(a.scalev + (size_t)bi * 6144 + c) + 1.f), sh = *(const f32x4*)(a.shiftv + (size_t)bi * 6144 + c);
#pragma unroll
                for (int rr = 0; rr < NR; ++rr) { v[rr][i] = (v[rr][i] * rstd[rr]) * gs + sh;
                    u32x2 w; w.x = pk2(v[rr][i][0], v[rr][i][1]); w.y = pk2(v[rr][i][2], v[rr][i][3]);
                    *(u32x2*)(a.u + (size_t)(row0 + rr) * D + c) = w; } }
            if (a.gw) {
                float acc[NR * 16];
                int lo4 = lane * 4; asm volatile("" : "+v"(lo4));
#pragma unroll
                for (int j = 0; j < NR * 16; ++j) acc[j] = 0.f;
#pragma unroll
                for (int j = 0; j < 16; ++j) {
#pragma unroll
                    for (int i = 0; i < 4; ++i) { const f32x4 w4 = *(const f32x4*)(gwT + j * 1024 + i * 256 + lo4);
#pragma unroll
                        for (int rr = 0; rr < NR; ++rr) acc[rr * 16 + j] += v[rr][i][0] * w4[0] + v[rr][i][1] * w4[1] + v[rr][i][2] * w4[2] + v[rr][i][3] * w4[3]; }
                    __builtin_amdgcn_sched_barrier(0); }
                if constexpr (NR == 4) { RN_STEP(32, 32) RN_STEP(16, 16) RN_STEP(8, 8) RN_STEP(4, 4) RN_STEP(2, 2) RN_STEP(1, 1)
                    a.gates[(size_t)row0 * 16 + lane] = acc[0]; }
                else { RN_STEP(8, 32) RN_STEP(4, 16) RN_STEP(2, 8) RN_STEP(1, 4)
                    float t_ = acc[0]; t_ += __shfl_xor(t_, 2); t_ += __shfl_xor(t_, 1);
                    if ((lane & 3) == 0) a.gates[(size_t)row0 * 16 + (lane >> 2)] = t_; }
            }
        }
    }
}

DI void phase_rownorm(const RNArgs& a, unsigned char* lds, int blk = -1, int nblk = 0) {
    if (a.row_begin == 0 && a.nrows == MT && blk < 0) {
        RNArgs l = a; l.nrows = ML; phase_rownorm_t<4, true>(l, lds);
        RNArgs c = a; c.nrows = MC; c.row_begin = ML; phase_rownorm_t<1, false>(c, lds);
    } else if (a.nrows == MC) phase_rownorm_t<1, true>(a, lds, blk, nblk);
    else phase_rownorm_t<4, true>(a, lds, blk, nblk);
}

DI void rope_pass(unsigned char* lds, bf16_t* P, int ld, int h0, int nheads) {
    float* cst = (float*)lds; float* snt = cst + 1024;
    for (int i = tidx(); i < 1024; i += NTHR) { const float inv = expf(-(float)(i & 15) * (9.210340371976184f / 16.f)); float sn, cs; sincosf((float)(i >> 4) * inv, &sn, &cs); cst[i] = cs; snt[i] = sn; }
    __syncthreads();
    const size_t total = (size_t)ML * nheads * 4;
    for (size_t w = (size_t)bidx() * NTHR + tidx(); w < total; w += (size_t)gridDim.x * NTHR) {
        const int sub = (int)(w & 3); const size_t rh = w >> 2; const int head = (int)(rh % nheads); const int row = (int)(rh / nheads);
        const int ax = sub >> 1, i8 = sub & 1, t = row & (T - 1);
        const int pos = ax == 0 ? (t >> 6) : (t & 63);
        bf16_t* ptr = P + (size_t)row * ld + (h0 + head) * 64 + ax * 32 + i8 * 8;
        const u32x4 a = *(const u32x4*)ptr, b = *(const u32x4*)(ptr + 16);
        const float sc = 1.f;
        const f32x4 c0 = *(const f32x4*)(cst + pos * 16 + i8 * 8), c1 = *(const f32x4*)(cst + pos * 16 + i8 * 8 + 4);
        const f32x4 s0 = *(const f32x4*)(snt + pos * 16 + i8 * 8), s1 = *(const f32x4*)(snt + pos * 16 + i8 * 8 + 4);
        const float csv[8] = {c0[0], c0[1], c0[2], c0[3], c1[0], c1[1], c1[2], c1[3]}, snv[8] = {s0[0], s0[1], s0[2], s0[3], s1[0], s1[1], s1[2], s1[3]};
        float x1[8] = {lo16(a.x), hi16(a.x), lo16(a.y), hi16(a.y), lo16(a.z), hi16(a.z), lo16(a.w), hi16(a.w)};
        float x2[8] = {lo16(b.x), hi16(b.x), lo16(b.y), hi16(b.y), lo16(b.z), hi16(b.z), lo16(b.w), hi16(b.w)};
        float o1[8], o2[8];
#pragma unroll
        for (int e = 0; e < 8; ++e) { o1[e] = (x1[e] * csv[e] - x2[e] * snv[e]) * sc; o2[e] = (x2[e] * csv[e] + x1[e] * snv[e]) * sc; }
        u32x4 ra, rb;
        ra.x = pk2(o1[0], o1[1]); ra.y = pk2(o1[2], o1[3]); ra.z = pk2(o1[4], o1[5]); ra.w = pk2(o1[6], o1[7]);
        rb.x = pk2(o2[0], o2[1]); rb.y = pk2(o2[2], o2[3]); rb.z = pk2(o2[4], o2[5]); rb.w = pk2(o2[6], o2[7]);
        *(u32x4*)ptr = ra; *(u32x4*)(ptr + 16) = rb;
    }
    __syncthreads();
}
DI void ctxq_scale(bf16_t* P, int ld) {
    const int total = MC * 64;
    for (int w = bidx() * NTHR + tidx(); w < total; w += gridDim.x * NTHR) {
        const int row = ML + (w >> 6), ch = w & 63; bf16_t* ptr = P + (size_t)row * ld + ch * 8;
        const u32x4 a = *(const u32x4*)ptr; u32x4 r;
        r.x = pk2(lo16(a.x) * QSCALE, hi16(a.x) * QSCALE); r.y = pk2(lo16(a.y) * QSCALE, hi16(a.y) * QSCALE);
        r.z = pk2(lo16(a.z) * QSCALE, hi16(a.z) * QSCALE); r.w = pk2(lo16(a.w) * QSCALE, hi16(a.w) * QSCALE);
        *(u32x4*)ptr = r;
    }
}
DI void conv5_pass(unsigned char* lds, const bf16_t* P, int ld, int col0, int ncols, const float* cwg, const float* cb, int nscale, bf16_t* O) {
    float* cw = (float*)(lds + 16384);
    for (int i = tidx(); i < 5 * ncols; i += NTHR) cw[i] = cwg[i];
    __syncthreads();
    const int nch = ncols / 8; const size_t total = (size_t)(MT / 4) * nch;
    for (size_t w = (size_t)bidx() * NTHR + tidx(); w < total; w += (size_t)gridDim.x * NTHR) {
        const int ch = (int)(w % nch), row0 = (int)(w / nch) * 4, c0 = ch * 8;
        int t0, len; if (row0 < ML) { t0 = row0 & (T - 1); len = T; } else { t0 = (row0 - ML) & (CT - 1); len = CT; }
        u32x4 xin[8];
#pragma unroll
        for (int j = 0; j < 8; ++j) { const int tt = t0 + j - 2; xin[j] = (tt < 0 || tt >= len) ? (u32x4){0u, 0u, 0u, 0u} : *(const u32x4*)(P + (size_t)(row0 + j - 2) * ld + col0 + c0); }
        float acc[4][8];
#pragma unroll
        for (int rr = 0; rr < 4; ++rr)
#pragma unroll
            for (int e = 0; e < 8; ++e) acc[rr][e] = cb ? cb[c0 + e] : 0.f;
#pragma unroll
        for (int j = 0; j < 5; ++j) { const f32x4 w0 = *(const f32x4*)(cw + (size_t)j * ncols + c0), w1 = *(const f32x4*)(cw + (size_t)j * ncols + c0 + 4);
#pragma unroll
            for (int rr = 0; rr < 4; ++rr) { const u32x4 a = xin[rr + j];
                acc[rr][0] += lo16(a.x) * w0[0]; acc[rr][1] += hi16(a.x) * w0[1]; acc[rr][2] += lo16(a.y) * w0[2]; acc[rr][3] += hi16(a.y) * w0[3];
                acc[rr][4] += lo16(a.z) * w1[0]; acc[rr][5] += hi16(a.z) * w1[1]; acc[rr][6] += lo16(a.w) * w1[2]; acc[rr][7] += hi16(a.w) * w1[3]; } }
        const float sc = c0 < nscale ? 0.125f : 1.f;
#pragma unroll
        for (int rr = 0; rr < 4; ++rr) { u32x4 r;
            r.x = pk2(silu_f(acc[rr][0]) * sc, silu_f(acc[rr][1]) * sc); r.y = pk2(silu_f(acc[rr][2]) * sc, silu_f(acc[rr][3]) * sc);
            r.z = pk2(silu_f(acc[rr][4]) * sc, silu_f(acc[rr][5]) * sc); r.w = pk2(silu_f(acc[rr][6]) * sc, silu_f(acc[rr][7]) * sc);
            *(u32x4*)(O + (size_t)(row0 + rr) * ncols + c0) = r; }
    }
}
DI void act_pass(const bf16_t* G, bf16_t* U, const float* cw, int nrows) {
    const int nch = FH / 8; const size_t total = (size_t)(nrows / 4) * nch;
    for (size_t w = (size_t)bidx() * NTHR + tidx(); w < total; w += (size_t)gridDim.x * NTHR) {
        const int ch = (int)(w % nch), row0 = (int)(w / nch) * 4, c0 = ch * 8;
        int t0, len; if (row0 < ML) { t0 = row0 & (T - 1); len = T; } else { t0 = (row0 - ML) & (CT - 1); len = CT; }
        u32x4 gin[6], uin[4];
#pragma unroll
        for (int j = 0; j < 6; ++j) { const int tt = t0 + j - 1; gin[j] = (tt < 0 || tt >= len) ? (u32x4){0u, 0u, 0u, 0u} : *(const u32x4*)(G + (size_t)(row0 + j - 1) * FH + c0); }
#pragma unroll
        for (int rr = 0; rr < 4; ++rr) uin[rr] = *(const u32x4*)(U + (size_t)(row0 + rr) * FH + c0);
        float acc[4][8];
#pragma unroll
        for (int rr = 0; rr < 4; ++rr)
#pragma unroll
            for (int e = 0; e < 8; ++e) acc[rr][e] = 0.f;
#pragma unroll
        for (int j = 0; j < 3; ++j) { const f32x4 w0 = *(const f32x4*)(cw + (size_t)j * FH + c0), w1 = *(const f32x4*)(cw + (size_t)j * FH + c0 + 4);
#pragma unroll
            for (int rr = 0; rr < 4; ++rr) { const u32x4 a = gin[rr + j];
                acc[rr][0] += lo16(a.x) * w0[0]; acc[rr][1] += hi16(a.x) * w0[1]; acc[rr][2] += lo16(a.y) * w0[2]; acc[rr][3] += hi16(a.y) * w0[3];
                acc[rr][4] += lo16(a.z) * w1[0]; acc[rr][5] += hi16(a.z) * w1[1]; acc[rr][6] += lo16(a.w) * w1[2]; acc[rr][7] += hi16(a.w) * w1[3]; } }
#pragma unroll
        for (int rr = 0; rr < 4; ++rr) { const u32x4 uu = uin[rr]; u32x4 r;
            r.x = pk2(silu_f(acc[rr][0]) * lo16(uu.x), silu_f(acc[rr][1]) * hi16(uu.x)); r.y = pk2(silu_f(acc[rr][2]) * lo16(uu.y), silu_f(acc[rr][3]) * hi16(uu.y));
            r.z = pk2(silu_f(acc[rr][4]) * lo16(uu.z), silu_f(acc[rr][5]) * hi16(uu.z)); r.w = pk2(silu_f(acc[rr][6]) * lo16(uu.w), silu_f(acc[rr][7]) * hi16(uu.w));
            *(u32x4*)(U + (size_t)(row0 + rr) * FH + c0) = r; }
    }
}

DI int swap23(int k) { return (k & ~12) | ((k & 4) << 1) | ((k & 8) >> 1); }
template <int DV, bool VTG>
DI void attn_run(unsigned char* lds, const bf16_t* P, int ld, int qrow, int qcol, const float* rope_tab, int qpos, int kcol, int vcol, const bf16_t* vtg, int vt_lat0,
                 int lat_row0, int n_lat, int ctx_row0, int n_ctx, bool windowed, int tq, int tk0, int tqw0,
                 float m_init, float l_init, f32x16 (&o)[DV / 32]) {
    constexpr int KSZ = 64 * 72, VSZ = DV * 72;
    bf16_t* Kb = (bf16_t*)lds;
    bf16_t* Vb = Kb + 2 * KSZ;
    const int tid = tidx(), lane = tid & 63, r = lane & 31, h = lane >> 5;
    constexpr int NV = DV / 64, NT = DV / 32;
    bf16x8 qf[4];
    {
        u32x4 qraw[4];
#pragma unroll
        for (int ks = 0; ks < 4; ++ks) qraw[ks] = *(const u32x4*)(P + (size_t)qrow * ld + qcol + ks * 16 + h * 8);
#pragma unroll
        for (int ax = 0; ax < 2; ++ax) {
            float cs[8], sn[8];
            if (rope_tab) { const int pos = ax == 0 ? (qpos >> 6) : (qpos & 63); const float* tb = rope_tab + pos * 16 + h * 8;
                const f32x4 c0 = *(const f32x4*)tb, c1 = *(const f32x4*)(tb + 4), s0 = *(const f32x4*)(tb + 1024), s1 = *(const f32x4*)(tb + 1028);
#pragma unroll
                for (int e = 0; e < 4; ++e) { cs[e] = c0[e]; cs[4 + e] = c1[e]; sn[e] = s0[e]; sn[4 + e] = s1[e]; } }
            else {
#pragma unroll
                for (int e = 0; e < 8; ++e) { cs[e] = 1.f; sn[e] = 0.f; } }
            const u32x4 a = qraw[2 * ax], b = qraw[2 * ax + 1];
            const float x1[8] = {lo16(a.x), hi16(a.x), lo16(a.y), hi16(a.y), lo16(a.z), hi16(a.z), lo16(a.w), hi16(a.w)};
            const float x2[8] = {lo16(b.x), hi16(b.x), lo16(b.y), hi16(b.y), lo16(b.z), hi16(b.z), lo16(b.w), hi16(b.w)};
            float o1[8], o2[8];
#pragma unroll
            for (int e = 0; e < 8; ++e) { o1[e] = (x1[e] * cs[e] - x2[e] * sn[e]) * QSCALE; o2[e] = (x2[e] * cs[e] + x1[e] * sn[e]) * QSCALE; }
            u32x4 ra, rb;
            ra.x = pk2(o1[0], o1[1]); ra.y = pk2(o1[2], o1[3]); ra.z = pk2(o1[4], o1[5]); ra.w = pk2(o1[6], o1[7]);
            rb.x = pk2(o2[0], o2[1]); rb.y = pk2(o2[2], o2[3]); rb.z = pk2(o2[4], o2[5]); rb.w = pk2(o2[6], o2[7]);
            qf[2 * ax] = __builtin_bit_cast(bf16x8, ra); qf[2 * ax + 1] = __builtin_bit_cast(bf16x8, rb);
        }
    }
#pragma unroll
    for (int d = 0; d < NT; ++d) o[d] = zero16();
    float m = m_init, l = l_init;
    const int ntile = n_lat + n_ctx;
    const int kkey = tid >> 3, kch = tid & 7, vkey = tid & 63, vch = tid >> 6, vkp = swap23(vkey);
    u32x4 kreg, vreg[NV];
#define ATT_LOAD(t1) do { const int tr_ = (t1) < n_lat ? lat_row0 + (t1) * 64 : ctx_row0 + ((t1) - n_lat) * 64; \
        kreg = *(const u32x4*)(P + (size_t)(tr_ + kkey) * ld + kcol + kch * 8); \
        if (VTG) { const int ki_ = (t1) < n_lat ? vt_lat0 + (t1) * 64 : 4096 + ((t1) - n_lat) * 64; \
            _Pragma("unroll") for (int i = 0; i < NV; ++i) { const int idx_ = tid + NTHR * i; vreg[i] = *(const u32x4*)(vtg + (size_t)(idx_ >> 3) * 4352 + ki_ + (idx_ & 7) * 8); } } \
        else { _Pragma("unroll") for (int i = 0; i < NV; ++i) vreg[i] = *(const u32x4*)(P + (size_t)(tr_ + vkey) * ld + vcol + (vch + 8 * i) * 8); } } while (0)
#define ATT_STORE(buf) do { *(u32x4*)(Kb + (buf) * KSZ + kkey * 72 + kch * 8) = kreg; \
        if (VTG) { _Pragma("unroll") for (int i = 0; i < NV; ++i) { const int idx_ = tid + NTHR * i; *(u32x4*)(Vb + (buf) * VSZ + (idx_ >> 3) * 72 + (idx_ & 7) * 8) = vreg[i]; } } \
        else { _Pragma("unroll") for (int i = 0; i < NV; ++i) { bf16_t* vp = Vb + (buf) * VSZ + (size_t)((vch + 8 * i) * 8) * 72 + vkp; const u32x4 v = vreg[i]; \
            vp[0 * 72] = (bf16_t)(v.x & 0xffff); vp[1 * 72] = (bf16_t)(v.x >> 16); vp[2 * 72] = (bf16_t)(v.y & 0xffff); vp[3 * 72] = (bf16_t)(v.y >> 16); \
            vp[4 * 72] = (bf16_t)(v.z & 0xffff); vp[5 * 72] = (bf16_t)(v.z >> 16); vp[6 * 72] = (bf16_t)(v.w & 0xffff); vp[7 * 72] = (bf16_t)(v.w >> 16); } } } while (0)
    ATT_LOAD(0);
    ATT_STORE(0);
    __syncthreads();
    for (int tt = 0; tt < ntile; ++tt) {
        const bool more = tt + 1 < ntile;
        if (more) ATT_LOAD(tt + 1);
        const bf16_t* Ks = Kb + (tt & 1) * KSZ; const bf16_t* VT = Vb + (tt & 1) * VSZ;
        const bool msk = windowed && tt < n_lat;
        const int tkt = tk0 + tt * 64;
        if (!(msk && (tkt > tqw0 + 31 + 128 || tkt + 63 < tqw0 - 128))) {
        f32x16 s[2];
#pragma unroll
        for (int kt = 0; kt < 2; ++kt) { s[kt] = zero16();
#pragma unroll
            for (int ks = 0; ks < 4; ++ks) { const bf16x8 a = *(const bf16x8*)(Ks + (kt * 32 + r) * 72 + ks * 16 + h * 8); s[kt] = MFMA32(a, qf[ks], s[kt]); } }
        float tmax = -1e30f;
#pragma unroll
        for (int kt = 0; kt < 2; ++kt)
#pragma unroll
            for (int i = 0; i < 16; ++i) { if (msk) { const int dd = tq - (tkt + kt * 32 + crow(i, h)); if (dd > 128 || dd < -128) s[kt][i] = -1e30f; } tmax = fmaxf(tmax, s[kt][i]); }
        tmax = fmaxf(tmax, xor32(tmax, h));
        const float mnew = (tmax > m + 8.f) ? tmax : m;
        if (__any(mnew != m)) {
            const float alpha = __builtin_amdgcn_exp2f(m - mnew);
            l *= alpha; m = mnew;
#pragma unroll
            for (int d = 0; d < NT; ++d)
#pragma unroll
                for (int i = 0; i < 16; ++i) o[d][i] *= alpha;
        }
        f32x2 ls2 = {0.f, 0.f}; const f32x2 m2 = {m, m};
#pragma unroll
        for (int kt = 0; kt < 2; ++kt)
#pragma unroll
            for (int i = 0; i < 8; ++i) { f32x2 sv = {s[kt][2 * i], s[kt][2 * i + 1]}; sv = sv - m2;
                f32x2 pv; pv.x = __builtin_amdgcn_exp2f(sv.x); pv.y = __builtin_amdgcn_exp2f(sv.y);
                s[kt][2 * i] = pv.x; s[kt][2 * i + 1] = pv.y; ls2 = ls2 + pv; }
        l += ls2.x + ls2.y;
#pragma unroll
        for (int kt = 0; kt < 2; ++kt)
#pragma unroll
            for (int st = 0; st < 2; ++st) { const bf16x8 pb = pack8(s[kt], st);
#pragma unroll
                for (int d = 0; d < NT; ++d) { const bf16x8 a = *(const bf16x8*)(VT + (size_t)(d * 32 + r) * 72 + kt * 32 + st * 16 + 8 * h); o[d] = MFMA32(a, pb, o[d]); } }
        }
        if (more) ATT_STORE((tt + 1) & 1);
        __syncthreads();
    }
#undef ATT_LOAD
#undef ATT_STORE
    const float lt = l + xor32(l, h), inv = 1.f / lt;
#pragma unroll
    for (int d = 0; d < NT; ++d)
#pragma unroll
        for (int i = 0; i < 16; ++i) o[d][i] *= inv;
}
DI void vt_pass(const Params& p, unsigned char* lds) {
    const bf16_t* P = (const bf16_t*)(p.ws + WS_BIG + BIG_P); bf16_t* VTg = (bf16_t*)(p.ws + WS_BIG + BIG_VT);
    bf16_t* tile = (bf16_t*)lds;
    const int tid = tidx(), vkey = tid & 63, vch = tid >> 6, vkp = swap23(vkey);
    for (int item = bidx(); item < 8 * 4 * 68; item += gridDim.x) {
        const int kt = item % 68, bh = item / 68, hh = bh & 3, b = bh >> 2;
        const int row = kt < 64 ? b * T + kt * 64 + vkey : ML + b * CT + (kt - 64) * 64 + vkey;
#pragma unroll
        for (int i = 0; i < 2; ++i) { const u32x4 v = *(const u32x4*)(P + (size_t)row * NP1 + 1024 + hh * 128 + (vch + 8 * i) * 8);
            bf16_t* vp = tile + (size_t)((vch + 8 * i) * 8) * 72 + vkp;
            vp[0 * 72] = (bf16_t)(v.x & 0xffff); vp[1 * 72] = (bf16_t)(v.x >> 16); vp[2 * 72] = (bf16_t)(v.y & 0xffff); vp[3 * 72] = (bf16_t)(v.y >> 16);
            vp[4 * 72] = (bf16_t)(v.z & 0xffff); vp[5 * 72] = (bf16_t)(v.z >> 16); vp[6 * 72] = (bf16_t)(v.w & 0xffff); vp[7 * 72] = (bf16_t)(v.w >> 16); }
        __syncthreads();
#pragma unroll
        for (int i = 0; i < 2; ++i) { const int idx = tid + NTHR * i, dv = idx >> 3, c = idx & 7;
            *(u32x4*)(VTg + ((size_t)bh * 128 + dv) * 4352 + kt * 64 + c * 8) = *(const u32x4*)(tile + (size_t)dv * 72 + c * 8); }
        __syncthreads();
    }
}

DI void gqa_item(const Params& p, unsigned char* lds, int item) {
    const bf16_t* P = (const bf16_t*)(p.ws + WS_BIG + BIG_P); bf16_t* Y = (bf16_t*)(p.ws + WS_UY);
    const int lane = tidx() & 63, w = tidx() >> 6, r = lane & 31, h = lane >> 5;
    f32x16 o[2]; int qrow, hq;
    if (item < 1024) {
        const int b = item >> 7; hq = (item >> 4) & 7; const int qb = item & 15;
        const int t0 = qb * 256, tlo = t0 - 128 < 0 ? 0 : t0 - 128, thi = t0 + 384 > T ? T : t0 + 384;
        qrow = b * T + t0 + w * 32 + r;
        attn_run<64, false>(lds, P, NP0, qrow, hq * 64, (const float*)(p.ws + WS_ROPE), t0 + w * 32 + r, 512 + (hq >> 2) * 64, 640 + (hq >> 2) * 64, nullptr, 0, b * T + tlo, (thi - tlo) / 64, ML + b * CT, 4,
                     true, t0 + w * 32 + r, tlo, t0 + w * 32, p.a_sink[hq] * LOG2E, h == 0 ? 1.f : 0.f, o);
    } else {
        const int it = item - 1024, b = it >> 3; hq = it & 7;
        qrow = ML + b * CT + w * 32 + r;
        attn_run<64, false>(lds, P, NP0, qrow, hq * 64, nullptr, 0, 512 + (hq >> 2) * 64, 640 + (hq >> 2) * 64, nullptr, 0, 0, 0, ML + b * CT, 4,
                     false, 0, 0, 0, p.a_sink[hq] * LOG2E, h == 0 ? 1.f : 0.f, o);
    }
#pragma unroll
    for (int d = 0; d < 2; ++d)
#pragma unroll
        for (int g = 0; g < 4; ++g) { u32x2 wv; wv.x = pk2(o[d][4 * g], o[d][4 * g + 1]); wv.y = pk2(o[d][4 * g + 2], o[d][4 * g + 3]);
            *(u32x2*)(Y + (size_t)qrow * D + hq * 64 + d * 32 + 8 * g + 4 * h) = wv; }
}
DI void diff_item(const Params& p, unsigned char* lds, int item, float lam, float lam_init) {
    const bf16_t* P = (const bf16_t*)(p.ws + WS_BIG + BIG_P); bf16_t* Y = (bf16_t*)(p.ws + WS_UY);
    const int lane = tidx() & 63, w = tidx() >> 6, r = lane & 31, h = lane >> 5;
    const int b = item >> 6, hh = (item >> 4) & 3, qb = item & 15;
    const int qrow = b * T + qb * 256 + w * 32 + r;
    f32x16 o0[4];
#pragma unroll 1
    for (int mm = 0; mm < 2; ++mm) {
        attn_run<128, true>(lds, P, NP1, qrow, hh * 128 + mm * 64, (const float*)(p.ws + WS_ROPE), qb * 256 + w * 32 + r, 512 + hh * 128 + mm * 64, 1024 + hh * 128, (const bf16_t*)(p.ws + WS_BIG + BIG_VT) + (size_t)(b * 4 + hh) * 128 * 4352, 0, b * T, 64, ML + b * CT, 4, false, 0, 0, 0, -1e30f, 0.f, o0);
        if (mm == 0) {
#pragma unroll
            for (int d = 0; d < 4; ++d)
#pragma unroll
                for (int g = 0; g < 4; ++g) { u32x2 wv; wv.x = pk2(o0[d][4 * g], o0[d][4 * g + 1]); wv.y = pk2(o0[d][4 * g + 2], o0[d][4 * g + 3]);
                    *(u32x2*)(Y + (size_t)qrow * D + hh * 128 + d * 32 + 8 * g + 4 * h) = wv; }
        }
    }
    float ss = 0.f;
#pragma unroll
    for (int d = 0; d < 4; ++d)
#pragma unroll
        for (int g = 0; g < 4; ++g) { const u32x2 pv = *(const u32x2*)(Y + (size_t)qrow * D + hh * 128 + d * 32 + 8 * g + 4 * h);
            const float v0 = lo16(pv.x) - lam * o0[d][4 * g], v1 = hi16(pv.x) - lam * o0[d][4 * g + 1], v2 = lo16(pv.y) - lam * o0[d][4 * g + 2], v3 = hi16(pv.y) - lam * o0[d][4 * g + 3];
            o0[d][4 * g] = v0; o0[d][4 * g + 1] = v1; o0[d][4 * g + 2] = v2; o0[d][4 * g + 3] = v3; ss += v0 * v0 + v1 * v1 + v2 * v2 + v3 * v3; }
    ss += __shfl_xor(ss, 32);
    const float rstd = rsqrtf(ss * (1.f / 128.f) + EPS) * (1.f - lam_init);
#pragma unroll
    for (int d = 0; d < 4; ++d)
#pragma unroll
        for (int g = 0; g < 4; ++g) { const int dv = d * 32 + 8 * g + 4 * h; const f32x4 gn = *(const f32x4*)(p.c_norm_g + hh * 128 + dv);
            u32x2 wv; wv.x = pk2(o0[d][4 * g] * rstd * gn[0], o0[d][4 * g + 1] * rstd * gn[1]); wv.y = pk2(o0[d][4 * g + 2] * rstd * gn[2], o0[d][4 * g + 3] * rstd * gn[3]);
            *(u32x2*)(Y + (size_t)qrow * D + hh * 128 + dv) = wv; }
}

template <int L> DI int chunk_row0(int b, int dir, int j) {
    constexpr int nctx = CT / L, nlat = T / L;
    if (j < nctx) { const int c = dir ? nctx - 1 - j : j; return ML + b * CT + c * L; }
    int c = j - nctx; c = dir ? nlat - 1 - c : c; return b * T + c * L;
}
template <int L> DI int chunk_j(bool is_ctx, int c, int dir) {
    constexpr int nctx = CT / L, nlat = T / L;
    return is_ctx ? (dir ? nctx - 1 - c : c) : nctx + (dir ? nlat - 1 - c : c);
}
DI float logsigmoid_f(float x) { return fminf(x, 0.f) - log1pf(expf(-fabsf(x))); }
DI float softplus_f(float x) { return fmaxf(x, 0.f) + log1pf(expf(-fabsf(x))); }

DI void mlstm_local_item(const Params& p, unsigned char* lds, int item) {
    const bf16_t* P = (const bf16_t*)(p.ws + WS_BIG + BIG_P); const bf16_t* QKB = (const bf16_t*)(p.ws + WS_BIG + BIG_CV);
    bf16_t* ST = (bf16_t*)(p.ws + WS_BIG + BIG_ST); float* SC = (float*)(p.ws + WS_SC); float* NS = (float*)(p.ws + WS_NS);
    const float* gates = (const float*)(p.ws + WS_GATES);
    bf16_t* VT = (bf16_t*)lds;
    bf16_t* KT = VT + 128 * 72;
    float* lf = (float*)(KT + 2 * 64 * 72); float* li = lf + 128; float* wg = li + 128;
    const int tid = tidx(), lane = tid & 63, w = tid >> 6, r = lane & 31, h2 = lane >> 5;
    const int cc = item % 68, bh = item / 68, hd = bh & 3, b = bh >> 2;
    const bool is_ctx = cc < 4; const int c = is_ctx ? cc : cc - 4;
    const int r0 = is_ctx ? ML + b * CT + c * 64 : b * T + c * 64;
    size_t sit[2];
#pragma unroll
    for (int d = 0; d < 2; ++d) sit[d] = (size_t)((b * 4 + hd) * 2 + d) * 68 + chunk_j<64>(is_ctx, c, d);
    if (tid < 128) { const int d = w, l = lane; const size_t row = r0 + l;
        li[tid] = gates[row * 16 + d * 4 + hd] + p.b_gate_b[d * 4 + hd];
        lf[tid] = logsigmoid_f(gates[row * 16 + 8 + d * 4 + hd] + p.b_gate_b[8 + d * 4 + hd]); }
    __syncthreads();
    if (tid < 128) { const int d = w, l = d ? 63 - lane : lane;
        const float bcv = wave_scan_add(lf[d * 64 + l], lane), btot = __shfl(bcv, 63);
        const float wv = btot - bcv + li[d * 64 + l], mx = wave_max(wv);
        wg[d * 64 + l] = expf(wv - mx);
        if (lane == 0) { SC[sit[d] * 8 + 0] = btot; SC[sit[d] * 8 + 1] = mx; } }
    __syncthreads();
    { const int l = tid & 63, ch = tid >> 6;
      const u32x4 kv = *(const u32x4*)(QKB + (size_t)(r0 + l) * 512 + 256 + hd * 64 + ch * 8);
      const float kf[8] = {lo16(kv.x), hi16(kv.x), lo16(kv.y), hi16(kv.y), lo16(kv.z), hi16(kv.z), lo16(kv.w), hi16(kv.w)};
#pragma unroll
      for (int d = 0; d < 2; ++d) { const float wl = wg[d * 64 + l]; bf16_t* kp = KT + (size_t)(d * 64 + ch * 8) * 72 + l;
#pragma unroll
          for (int e = 0; e < 8; ++e) kp[e * 72] = f2bf(kf[e] * wl); }
#pragma unroll
      for (int it = 0; it < 2; ++it) { const int c8 = ch + 8 * it;
          const u32x4 vv = *(const u32x4*)(P + (size_t)(r0 + l) * NP0 + 1280 + hd * 128 + c8 * 8);
          bf16_t* vp = VT + (size_t)(c8 * 8) * 72 + l;
          vp[0] = (bf16_t)(vv.x & 0xffff); vp[72] = (bf16_t)(vv.x >> 16); vp[144] = (bf16_t)(vv.y & 0xffff); vp[216] = (bf16_t)(vv.y >> 16);
          vp[288] = (bf16_t)(vv.z & 0xffff); vp[360] = (bf16_t)(vv.z >> 16); vp[432] = (bf16_t)(vv.w & 0xffff); vp[504] = (bf16_t)(vv.w >> 16); } }
    __syncthreads();
    { const int rt = w >> 1, ct = w & 1; f32x16 acc[2] = {zero16(), zero16()};
#pragma unroll
      for (int ks = 0; ks < 4; ++ks) { const bf16x8 a = *(const bf16x8*)(VT + (size_t)(rt * 32 + r) * 72 + ks * 16 + h2 * 8);
#pragma unroll
          for (int d = 0; d < 2; ++d) { const bf16x8 bb = *(const bf16x8*)(KT + (size_t)(d * 64 + ct * 32 + r) * 72 + ks * 16 + h2 * 8); acc[d] = MFMA32(a, bb, acc[d]); } }
#pragma unroll
      for (int d = 0; d < 2; ++d) { bf16_t* dst = ST + sit[d] * 8192;
#pragma unroll
          for (int i = 0; i < 16; ++i) dst[(size_t)(rt * 32 + crow(i, h2)) * 64 + ct * 32 + r] = f2bf(acc[d][i]); } }
    if (tid < 128) { const int d = w; float acc = 0.f;
        for (int l = 0; l < 64; l += 2) { const unsigned kk = *(const unsigned*)(KT + (size_t)(d * 64 + lane) * 72 + l); acc += lo16(kk) + hi16(kk); }
        NS[sit[d] * 64 + lane] = acc; }
    __syncthreads();
}
DI void mlstm_scan(const Params& p, unsigned char* lds) {
    bf16_t* ST = (bf16_t*)(p.ws + WS_BIG + BIG_ST); float* SC = (float*)(p.ws + WS_SC); float* NS = (float*)(p.ws + WS_NS);
    float* av = (float*)lds; float* gv = av + 68;
    const int tid = tidx();
    for (int blk = bidx(); blk < 256; blk += gridDim.x) {
        const int seq = blk >> 2, e4 = (blk & 3) * 512 + tid;
        float* blv = gv + 68; float* mlv = blv + 68; float* m0v = mlv + 68;
        if (tid < 68) { const size_t item = (size_t)seq * 68 + tid; blv[tid] = SC[item * 8 + 0]; mlv[tid] = SC[item * 8 + 1]; }
        __syncthreads();
        if (tid == 0) { float m = 0.f;
            for (int j = 0; j < 68; ++j) { const float bl = blv[j], ml = mlv[j];
                const float mnew = fmaxf(bl + m, ml); av[j] = __expf(bl + m - mnew); gv[j] = __expf(ml - mnew);
                m0v[j] = m; m = mnew; } }
        __syncthreads();
        if ((blk & 3) == 0 && tid < 68) SC[((size_t)seq * 68 + tid) * 8 + 2] = m0v[tid];
        float st[4] = {0.f, 0.f, 0.f, 0.f}, ns = 0.f;
        bf16_t* base = ST + ((size_t)seq * 68) * 8192 + e4 * 4;
        u32x2 ring[4];
#pragma unroll
        for (int q = 0; q < 4; ++q) ring[q] = *(const u32x2*)(base + (size_t)q * 8192);
        const bool do_n = (blk & 3) == 0 && tid < 64;
#pragma unroll 4
        for (int j = 0; j < 68; ++j) {
            const u32x2 cur = ring[j & 3];
            if (j + 4 < 68) ring[j & 3] = *(const u32x2*)(base + (size_t)(j + 4) * 8192);
            const float a = av[j], g = gv[j];
            u32x2 o; o.x = pk2(st[0], st[1]); o.y = pk2(st[2], st[3]);
            *(u32x2*)(base + (size_t)j * 8192) = o;
            st[0] = a * st[0] + g * lo16(cur.x); st[1] = a * st[1] + g * hi16(cur.x); st[2] = a * st[2] + g * lo16(cur.y); st[3] = a * st[3] + g * hi16(cur.y);
            if (do_n) { float* np = NS + ((size_t)seq * 68 + j) * 64 + tid; const float nl = *np; *np = ns; ns = a * ns + g * nl; }
        }
        __syncthreads();
    }
}
DI void mlstm_out_item(const Params& p, unsigned char* lds, int item) {
    const bf16_t* P = (const bf16_t*)(p.ws + WS_BIG + BIG_P); const bf16_t* QKB = (const bf16_t*)(p.ws + WS_BIG + BIG_CV);
    const bf16_t* ST = (const bf16_t*)(p.ws + WS_BIG + BIG_ST); const float* SC = (const float*)(p.ws + WS_SC); const float* NS = (const float*)(p.ws + WS_NS);
    const float* gates = (const float*)(p.ws + WS_GATES); bf16_t* Y = (bf16_t*)(p.ws + WS_UY);
    bf16_t* Ks = (bf16_t*)lds;
    bf16_t* VT = Ks + 64 * 72;
    bf16_t* C0 = VT + 128 * 72;
    float* n0 = (float*)(C0 + 2 * 128 * 72);
    float* m0s = n0 + 128;
    float* lf = m0s + 8;
    float* li = lf + 128; float* bc = li + 128; float* c1 = bc + 128; float* pm = c1 + 128; float* red = pm + 128;
    const int tid = tidx(), lane = tid & 63, w = tid >> 6, r = lane & 31, h2 = lane >> 5;
    const int cc = item % 68, bh = item / 68, hd = bh & 3, b = bh >> 2;
    const bool is_ctx = cc < 4; const int c = is_ctx ? cc : cc - 4;
    const int r0 = is_ctx ? ML + b * CT + c * 64 : b * T + c * 64;
    const int tt = w & 1, vp = w >> 1, t = tt * 32 + r;
    if (tid < 128) { const int d = tid >> 6, l = tid & 63; const size_t row = r0 + l;
        li[tid] = gates[row * 16 + d * 4 + hd] + p.b_gate_b[d * 4 + hd];
        lf[tid] = logsigmoid_f(gates[row * 16 + 8 + d * 4 + hd] + p.b_gate_b[8 + d * 4 + hd]); }
    __syncthreads();
    if (tid < 128) { const int d = w, l = d ? 63 - lane : lane;
        const float bcv = wave_scan_add(lf[d * 64 + l], lane), cv = li[d * 64 + l] - bcv;
        bc[d * 64 + l] = bcv; c1[d * 64 + l] = cv; pm[d * 64 + l] = wave_scan_max(cv, lane); }
    { const int s = tid >> 3, ch = tid & 7;
      *(u32x4*)(Ks + (size_t)s * 72 + ch * 8) = *(const u32x4*)(QKB + (size_t)(r0 + s) * 512 + 256 + hd * 64 + ch * 8);
      const int l = tid & 63, c8 = tid >> 6;
#pragma unroll
      for (int it = 0; it < 2; ++it) { const int cq = c8 + 8 * it;
          const u32x4 vv = *(const u32x4*)(P + (size_t)(r0 + l) * NP0 + 1280 + hd * 128 + cq * 8);
          bf16_t* vq = VT + (size_t)(cq * 8) * 72 + l;
          vq[0] = (bf16_t)(vv.x & 0xffff); vq[72] = (bf16_t)(vv.x >> 16); vq[144] = (bf16_t)(vv.y & 0xffff); vq[216] = (bf16_t)(vv.y >> 16);
          vq[288] = (bf16_t)(vv.z & 0xffff); vq[360] = (bf16_t)(vv.z >> 16); vq[432] = (bf16_t)(vv.w & 0xffff); vq[504] = (bf16_t)(vv.w >> 16); } }
    bf16x8 qf[4];
#pragma unroll
    for (int ks = 0; ks < 4; ++ks) qf[ks] = *(const bf16x8*)(QKB + (size_t)(r0 + t) * 512 + hd * 64 + ks * 16 + h2 * 8);
#pragma unroll
    for (int d = 0; d < 2; ++d) {
        const size_t sit = (size_t)((b * 4 + hd) * 2 + d) * 68 + chunk_j<64>(is_ctx, c, d);
#pragma unroll
        for (int it = 0; it < 2; ++it) { const int idx = tid + NTHR * it, dv = idx >> 3, ch = idx & 7;
            *(u32x4*)(C0 + (size_t)(d * 128 + dv) * 72 + ch * 8) = *(const u32x4*)(ST + sit * 8192 + dv * 64 + ch * 8); }
        if (tid < 64) n0[d * 64 + tid] = NS[sit * 64 + tid];
        if (tid == 64) m0s[d] = SC[sit * 8 + 2]; }
    __syncthreads();
    f32x16 x[2];
#pragma unroll
    for (int st = 0; st < 2; ++st) { x[st] = zero16();
#pragma unroll
        for (int ks = 0; ks < 4; ++ks) { const bf16x8 a = *(const bf16x8*)(Ks + (size_t)(st * 32 + r) * 72 + ks * 16 + h2 * 8); x[st] = MFMA32(a, qf[ks], x[st]); } }
    f32x16 hsum = zero16();
#pragma unroll 1
    for (int d = 0; d < 2; ++d) {
        const float m0 = m0s[d];
        const float mx = fmaxf(pm[d * 64 + t], m0), ain = __expf(m0 - mx);
        f32x16 wv[2]; float sumw = 0.f;
#pragma unroll
        for (int st = 0; st < 2; ++st)
#pragma unroll
            for (int i = 0; i < 16; ++i) { const int s = st * 32 + crow(i, h2); const bool valid = d ? (s >= t) : (s <= t);
                const float v = valid ? x[st][i] * __expf(c1[d * 64 + s] - mx) : 0.f; wv[st][i] = v; sumw += v; }
        sumw += __shfl_xor(sumw, 32);
        f32x16 acc = zero16(), acc2 = zero16();
#pragma unroll
        for (int st = 0; st < 2; ++st)
#pragma unroll
            for (int sb = 0; sb < 2; ++sb) { const bf16x8 pb = pack8(wv[st], sb);
                const bf16x8 a = ld_tr2(VT + (size_t)(vp * 32 + r) * 72 + st * 32 + sb * 16 + 4 * h2); acc = MFMA32(a, pb, acc); }
        float nq = 0.f;
#pragma unroll
        for (int ks = 0; ks < 4; ++ks) { const bf16x8 a = *(const bf16x8*)(C0 + (size_t)(d * 128 + vp * 32 + r) * 72 + ks * 16 + h2 * 8); acc2 = MFMA32(a, qf[ks], acc2);
#pragma unroll
            for (int e = 0; e < 8; ++e) nq += n0[d * 64 + ks * 16 + h2 * 8 + e] * bf2f((bf16_t)qf[ks][e]); }
        nq += __shfl_xor(nq, 32);
        float den = sumw + ain * nq; const float mt = bc[d * 64 + t] + mx;
        den = fmaxf(fabsf(den), __expf(-mt));
        const float rden = 1.f / den;
#pragma unroll
        for (int i = 0; i < 16; ++i) hsum[i] += (acc[i] + ain * acc2[i]) * rden;
    }
    float ss = 0.f;
#pragma unroll
    for (int i = 0; i < 16; ++i) ss += hsum[i] * hsum[i];
    ss += __shfl_xor(ss, 32);
    if (h2 == 0) red[vp * 64 + t] = ss;
    __syncthreads();
    const float rstd = rsqrtf((red[t] + red[64 + t] + red[128 + t] + red[192 + t]) * (1.f / 128.f) + EPS);
#pragma unroll
    for (int g = 0; g < 4; ++g) { const int dv = vp * 32 + 8 * g + 4 * h2;
        const u32x2 og = *(const u32x2*)(P + (size_t)(r0 + t) * NP0 + 1792 + hd * 128 + dv); const f32x4 gn = *(const f32x4*)(p.b_norm_g + hd * 128 + dv);
        u32x2 wv2; wv2.x = pk2(hsum[4 * g] * rstd * gn[0] * sigmoid_f(lo16(og.x)), hsum[4 * g + 1] * rstd * gn[1] * sigmoid_f(hi16(og.x)));
        wv2.y = pk2(hsum[4 * g + 2] * rstd * gn[2] * sigmoid_f(lo16(og.y)), hsum[4 * g + 3] * rstd * gn[3] * sigmoid_f(hi16(og.y)));
        *(u32x2*)(Y + (size_t)(r0 + t) * D + 512 + hd * 128 + dv) = wv2; }
    __syncthreads();
}

DI void ssd_local_item(const Params& p, unsigned char* lds, int item) {
    const bf16_t* XBC = (const bf16_t*)(p.ws + WS_BIG + BIG_CV);
    bf16_t* ST = (bf16_t*)(p.ws + WS_BIG + BIG_ST); float* SC = (float*)(p.ws + WS_SC); const float* gates = (const float*)(p.ws + WS_GATES);
    bf16_t* KT = (bf16_t*)lds;
    bf16_t* VT = KT + 128 * 136;
    float* av = (float*)(VT + 256 * 136); float* dtv = av + 512; float* ac = dtv + 512; float* wg = ac + 512; float* scal = wg + 512;
    const int tid = tidx(), lane = tid & 63, w = tid >> 6, r = lane & 31, h2 = lane >> 5;
    const int j = item % 34, seq = item / 34, dir = seq & 1, grp = (seq >> 1) & 1, b = seq >> 2;
    const int r0 = chunk_row0<128>(b, dir, j);
    { const int hh = tid >> 7, l = tid & 127, head = grp * 4 + hh;
      const float dt = softplus_f(gates[(size_t)(r0 + l) * 16 + dir * 8 + head] + p.d_dt_bias[dir * 8 + head]);
      dtv[tid] = dt; av[tid] = -dt * expf(p.d_a_log[dir * 8 + head]); }
    __syncthreads();
    if (tid < 256) { const int hh = w, l0 = dir ? 127 - 2 * lane : 2 * lane, l1 = dir ? 126 - 2 * lane : 2 * lane + 1;
        const float a0 = av[hh * 128 + l0], a1 = av[hh * 128 + l1], pv = wave_scan_add(a0 + a1, lane), tot = __shfl(pv, 63);
        ac[hh * 128 + l1] = pv; ac[hh * 128 + l0] = pv - a1;
        if (lane == 0) { scal[hh] = tot; SC[(size_t)item * 8 + hh] = tot; } }
    __syncthreads();
    { const int hh = tid >> 7; wg[tid] = expf(scal[hh] - ac[tid]) * dtv[tid]; }
    __syncthreads();
    { const int l = tid & 127, c4 = tid >> 7;
#pragma unroll
      for (int it = 0; it < 4; ++it) { const int ch = c4 + 4 * it;
          const u32x4 kv = *(const u32x4*)(XBC + (size_t)(r0 + l) * 1024 + 512 + grp * 128 + ch * 8);
          bf16_t* kp = KT + (size_t)(ch * 8) * 136 + l;
          kp[0] = (bf16_t)(kv.x & 0xffff); kp[136] = (bf16_t)(kv.x >> 16); kp[272] = (bf16_t)(kv.y & 0xffff); kp[408] = (bf16_t)(kv.y >> 16);
          kp[544] = (bf16_t)(kv.z & 0xffff); kp[680] = (bf16_t)(kv.z >> 16); kp[816] = (bf16_t)(kv.w & 0xffff); kp[952] = (bf16_t)(kv.w >> 16); }
#pragma unroll
      for (int it = 0; it < 8; ++it) { const int ch = c4 + 4 * it, hh = ch >> 3; const float wl = wg[hh * 128 + l];
          const u32x4 vv = *(const u32x4*)(XBC + (size_t)(r0 + l) * 1024 + grp * 256 + ch * 8);
          bf16_t* vp = VT + (size_t)(ch * 8) * 136 + l;
          vp[0] = f2bf(lo16(vv.x) * wl); vp[136] = f2bf(hi16(vv.x) * wl); vp[272] = f2bf(lo16(vv.y) * wl); vp[408] = f2bf(hi16(vv.y) * wl);
          vp[544] = f2bf(lo16(vv.z) * wl); vp[680] = f2bf(hi16(vv.z) * wl); vp[816] = f2bf(lo16(vv.w) * wl); vp[952] = f2bf(hi16(vv.w) * wl); } }
    __syncthreads();
    { f32x16 acc[4];
#pragma unroll
      for (int ct = 0; ct < 4; ++ct) acc[ct] = zero16();
#pragma unroll
      for (int ks = 0; ks < 8; ++ks) { const bf16x8 a = *(const bf16x8*)(VT + (size_t)(w * 32 + r) * 136 + ks * 16 + h2 * 8);
#pragma unroll
          for (int ct = 0; ct < 4; ++ct) { const bf16x8 bb = *(const bf16x8*)(KT + (size_t)(ct * 32 + r) * 136 + ks * 16 + h2 * 8); acc[ct] = MFMA32(a, bb, acc[ct]); } }
      bf16_t* dst = ST + (size_t)item * 32768;
#pragma unroll
      for (int ct = 0; ct < 4; ++ct)
#pragma unroll
          for (int i = 0; i < 16; ++i) dst[(size_t)(w * 32 + crow(i, h2)) * 128 + ct * 32 + r] = f2bf(acc[ct][i]); }
    __syncthreads();
}
DI void ssd_scan(const Params& p, unsigned char* lds) {
    bf16_t* ST = (bf16_t*)(p.ws + WS_BIG + BIG_ST); const float* SC = (const float*)(p.ws + WS_SC);
    float* dec = (float*)lds;
    const int tid = tidx();
    for (int blk = bidx(); blk < 256; blk += gridDim.x) {
        const int seq = blk >> 3, e8 = (blk & 7) * 512 + tid, hh = e8 >> 10;
        if (tid < 136) dec[tid] = expf(SC[((size_t)seq * 34 + (tid >> 2)) * 8 + (tid & 3)]);
        __syncthreads();
        float st[8];
#pragma unroll
        for (int e = 0; e < 8; ++e) st[e] = 0.f;
        bf16_t* base = ST + ((size_t)seq * 34) * 32768 + e8 * 8;
        u32x4 ring[4];
#pragma unroll
        for (int q = 0; q < 4; ++q) ring[q] = *(const u32x4*)(base + (size_t)q * 32768);
#pragma unroll 4
        for (int j = 0; j < 34; ++j) {
            const u32x4 cur = ring[j & 3];
            if (j + 4 < 34) ring[j & 3] = *(const u32x4*)(base + (size_t)(j + 4) * 32768);
            const float a = dec[j * 4 + hh];
            u32x4 o; o.x = pk2(st[0], st[1]); o.y = pk2(st[2], st[3]); o.z = pk2(st[4], st[5]); o.w = pk2(st[6], st[7]);
            *(u32x4*)(base + (size_t)j * 32768) = o;
            st[0] = a * st[0] + lo16(cur.x); st[1] = a * st[1] + hi16(cur.x); st[2] = a * st[2] + lo16(cur.y); st[3] = a * st[3] + hi16(cur.y);
            st[4] = a * st[4] + lo16(cur.z); st[5] = a * st[5] + hi16(cur.z); st[6] = a * st[6] + lo16(cur.w); st[7] = a * st[7] + hi16(cur.w);
        }
        __syncthreads();
    }
}
DI void ssd_out_item(const Params& p, unsigned char* lds, int item) {
    const bf16_t* P = (const bf16_t*)(p.ws + WS_BIG + BIG_P); const bf16_t* XBC = (const bf16_t*)(p.ws + WS_BIG + BIG_CV);
    const bf16_t* ST = (const bf16_t*)(p.ws + WS_BIG + BIG_ST); const float* gates = (const float*)(p.ws + WS_GATES); bf16_t* Y = (bf16_t*)(p.ws + WS_UY);
    bf16_t* Bs = (bf16_t*)lds;
    bf16_t* XT = Bs + 128 * 136;
    bf16_t* H0 = XT + 256 * 136;
    float* ac = (float*)(H0 + 64 * 136);
    float* dtv = ac + 1024; float* red = dtv + 1024;
    const int tid = tidx(), lane = tid & 63, w = tid >> 6, r = lane & 31, h2 = lane >> 5;
    const int c = item & 31, bg = item >> 5, grp = bg & 1, b = bg >> 1;
    const int r0 = b * T + c * 128;
    const int tt = w & 3, pp = w >> 2, t = tt * 32 + r;
#pragma unroll
    for (int it = 0; it < 2; ++it) { const int idx = tid + NTHR * it, d = idx >> 9, hh = (idx >> 7) & 3, l = idx & 127, head = grp * 4 + hh;
        const float dt = softplus_f(gates[(size_t)(r0 + l) * 16 + d * 8 + head] + p.d_dt_bias[d * 8 + head]);
        dtv[idx] = dt; ac[idx] = -dt * expf(p.d_a_log[d * 8 + head]); }
    __syncthreads();
    { const int d = w >> 2, l0 = d ? 127 - 2 * lane : 2 * lane, l1 = d ? 126 - 2 * lane : 2 * lane + 1;
      const float a0 = ac[w * 128 + l0], a1 = ac[w * 128 + l1], pv = wave_scan_add(a0 + a1, lane);
      ac[w * 128 + l1] = pv; ac[w * 128 + l0] = pv - a1;
      dtv[w * 128 + l1] = pv * LOG2E - __log2f(dtv[w * 128 + l1]); dtv[w * 128 + l0] = (pv - a1) * LOG2E - __log2f(dtv[w * 128 + l0]); }
    { const int l = tid & 127, c4 = tid >> 7;
#pragma unroll
      for (int it = 0; it < 4; ++it) { const int ch = c4 + 4 * it;
          *(u32x4*)(Bs + (size_t)l * 136 + ch * 8) = *(const u32x4*)(XBC + (size_t)(r0 + l) * 1024 + 512 + grp * 128 + ch * 8); }
#pragma unroll
      for (int it = 0; it < 8; ++it) { const int ch = c4 + 4 * it;
          const u32x4 vv = *(const u32x4*)(XBC + (size_t)(r0 + l) * 1024 + grp * 256 + ch * 8);
          bf16_t* vp = XT + (size_t)(ch * 8) * 136 + l;
          vp[0] = (bf16_t)(vv.x & 0xffff); vp[136] = (bf16_t)(vv.x >> 16); vp[272] = (bf16_t)(vv.y & 0xffff); vp[408] = (bf16_t)(vv.y >> 16);
          vp[544] = (bf16_t)(vv.z & 0xffff); vp[680] = (bf16_t)(vv.z >> 16); vp[816] = (bf16_t)(vv.w & 0xffff); vp[952] = (bf16_t)(vv.w >> 16); } }
    __syncthreads();
    f32x16 x[4];
#pragma unroll
    for (int st = 0; st < 4; ++st) x[st] = zero16();
    bf16x8 qfr[8];
#pragma unroll
    for (int ks = 0; ks < 8; ++ks) qfr[ks] = *(const bf16x8*)(XBC + (size_t)(r0 + t) * 1024 + 768 + grp * 128 + ks * 16 + h2 * 8);
#pragma unroll
    for (int ks = 0; ks < 8; ++ks) {
#pragma unroll
        for (int st = 0; st < 4; ++st) { const bf16x8 a = *(const bf16x8*)(Bs + (size_t)(st * 32 + r) * 136 + ks * 16 + h2 * 8); x[st] = MFMA32(a, qfr[ks], x[st]); } }
    float ssq = 0.f;
#pragma unroll 1
    for (int hh = 0; hh < 4; ++hh) {
        const int head = grp * 4 + hh;
        f32x16 ysum = zero16();
#pragma unroll 1
        for (int d = 0; d < 2; ++d) {
            const size_t sit = (size_t)((b * 2 + grp) * 2 + d) * 34 + chunk_j<128>(false, c, d);
            bf16x8 h0f[8];
#pragma unroll
            for (int ks = 0; ks < 8; ++ks) h0f[ks] = *(const bf16x8*)(ST + sit * 32768 + (size_t)(hh * 64 + pp * 32 + r) * 128 + ks * 16 + h2 * 8);
            const float* acd = ac + (d * 4 + hh) * 128; const float* dtd = dtv + (d * 4 + hh) * 128;
            const float at = acd[t], atl = at * LOG2E;
            f32x16 acc = zero16(), acc2 = zero16();
#pragma unroll
            for (int st = 0; st < 4; ++st) {
                if (d ? (st < tt) : (st > tt)) continue;
#pragma unroll
                for (int sb = 0; sb < 2; ++sb) { f32x16 wv;
#pragma unroll
                    for (int e = 0; e < 8; ++e) { const int i = 8 * sb + e, s = st * 32 + crow(i, h2); const bool valid = d ? (s >= t) : (s <= t);
                        wv[i] = valid ? x[st][i] * __builtin_amdgcn_exp2f(atl - dtd[s]) : 0.f; }
                    const bf16x8 pb = pack8(wv, sb);
                    const bf16x8 a = ld_tr2(XT + (size_t)(hh * 64 + pp * 32 + r) * 136 + st * 32 + sb * 16 + 4 * h2); acc = MFMA32(a, pb, acc); } }
#pragma unroll
            for (int ks = 0; ks < 8; ++ks) acc2 = MFMA32(h0f[ks], qfr[ks], acc2);
            const float ea = __expf(at);
#pragma unroll
            for (int i = 0; i < 16; ++i) ysum[i] += acc[i] + ea * acc2[i];
        }
        const float skp = p.d_skip[head];
#pragma unroll
        for (int g = 0; g < 4; ++g) { const int pcol = pp * 32 + 8 * g + 4 * h2;
            const u32x2 zz = *(const u32x2*)(P + (size_t)(r0 + t) * NP1 + 1536 + head * 64 + pcol);
            float yv[4];
            const float zf[4] = {lo16(zz.x), hi16(zz.x), lo16(zz.y), hi16(zz.y)};
#pragma unroll
            for (int e = 0; e < 4; ++e) { const float xv = bf2f(XT[(size_t)(hh * 64 + pcol + e) * 136 + t]); yv[e] = (ysum[4 * g + e] + skp * xv) * silu_f(zf[e]); ssq += yv[e] * yv[e]; }
            u32x2 wv2; wv2.x = pk2(yv[0], yv[1]); wv2.y = pk2(yv[2], yv[3]);
            *(u32x2*)(Y + (size_t)(r0 + t) * D + 512 + head * 64 + pcol) = wv2; }
    }
    ssq += __shfl_xor(ssq, 32);
    if (h2 == 0) red[pp * 128 + t] = ssq;
    __syncthreads();
    const float rstd = rsqrtf((red[t] + red[128 + t]) * (1.f / 256.f) + EPS);
#pragma unroll
    for (int hh = 0; hh < 4; ++hh)
#pragma unroll
        for (int g = 0; g < 4; ++g) { const int head = grp * 4 + hh, pcol = pp * 32 + 8 * g + 4 * h2;
            bf16_t* yp = Y + (size_t)(r0 + t) * D + 512 + head * 64 + pcol; const u32x2 yy = *(const u32x2*)yp; const f32x4 gn = *(const f32x4*)(p.d_norm_g + head * 64 + pcol);
            u32x2 wv2; wv2.x = pk2(lo16(yy.x) * rstd * gn[0], hi16(yy.x) * rstd * gn[1]); wv2.y = pk2(lo16(yy.y) * rstd * gn[2], hi16(yy.y) * rstd * gn[3]);
            *(u32x2*)yp = wv2; }
    __syncthreads();
}

#define XB_TMO      128
#define XB_XCNT(j)  (256  + 64 * (j))
#define XB_XSUB(j)  (1280 + 64 * (j))
#define XB_XGEN(j)  (2304 + 64 * (j))
#define XB_TOP      3328
#define XB_TOPGEN   3392
#define XCD_BAR_WORDS 3456
#define XB_SPIN_CAP (1u << 18)

__device__ __forceinline__ unsigned xb_ld(unsigned* p)              { return __hip_atomic_load(p, __ATOMIC_RELAXED, __HIP_MEMORY_SCOPE_AGENT); }
__device__ __forceinline__ unsigned xb_add(unsigned* p, unsigned v) { return __hip_atomic_fetch_add(p, v, __ATOMIC_RELAXED, __HIP_MEMORY_SCOPE_AGENT); }
__device__ __forceinline__ unsigned xb_xcc_id() { return (unsigned)__builtin_amdgcn_s_getreg((3 << 11) | 20) & 0xFu; }
#define XB_SPIN(cond, bar) do { unsigned _sp = 0; while (cond) { __builtin_amdgcn_s_sleep(1); \
    if ((++_sp & 255u) == 0u) { if (xb_ld(&(bar)[XB_TMO])) break; if (_sp > XB_SPIN_CAP) { atomicAdd(&(bar)[XB_TMO], 1u); break; } } } } while (0)

struct XcdBarrier {
    unsigned* bar; unsigned x;
    volatile LAS unsigned* st;
};

__device__ __forceinline__ XcdBarrier xcd_barrier_post(unsigned* bar, volatile LAS unsigned* st) {
    XcdBarrier b; b.bar = bar; b.x = xb_xcc_id(); b.st = st;
    if (threadIdx.x == 0) (void)xb_add(&bar[XB_XCNT(b.x)], 1u);
    return b;
}
__device__ __forceinline__ void xcd_barrier_complete(unsigned* bar, unsigned x, unsigned& nloc, unsigned& nx) {
    const unsigned G = gridDim.x * gridDim.y * gridDim.z;
    unsigned sum, cnt, mine, sp = 0u;
    for (;;) {
        sum = 0u; cnt = 0u; mine = 0u;
#pragma unroll
        for (unsigned j = 0; j < 16; ++j) { const unsigned c = xb_ld(&bar[XB_XCNT(j)]); sum += c; cnt += (c > 0u) ? 1u : 0u; mine = (j == x) ? c : mine; }
        if (sum == G) break;
        __builtin_amdgcn_s_sleep(1);
        if ((++sp & 255u) == 0u) { if (xb_ld(&bar[XB_TMO])) break; if (sp > XB_SPIN_CAP) { atomicAdd(&bar[XB_TMO], 1u); break; } }
    }
    nloc = mine > 0u ? mine : 1u; nx = cnt > 0u ? cnt : 1u;
}

__device__ __forceinline__ void xcd_barrier(const XcdBarrier& b) {
    asm volatile("s_waitcnt vmcnt(0)" ::: "memory");
    __syncthreads();
    if (threadIdx.x == 0) {
        unsigned* bar = b.bar;
        __builtin_amdgcn_s_waitcnt(0);
        unsigned nloc = b.st[0], nx = b.st[1];
        if (nloc == 0u) { xcd_barrier_complete(bar, b.x, nloc, nx); b.st[0] = nloc; b.st[1] = nx; }
        const unsigned old = xb_add(&bar[XB_XSUB(b.x)], 1u);
        const unsigned gen = old / nloc;
        if (old + 1u == (gen + 1u) * nloc) {
            __builtin_amdgcn_fence(__ATOMIC_RELEASE, "agent");
            asm volatile("s_waitcnt vmcnt(0)" ::: "memory");
            const unsigned og = xb_add(&bar[XB_TOP], 1u);
            const unsigned tg = og / nx;
            if (og + 1u == (tg + 1u) * nx) xb_add(&bar[XB_TOPGEN], 1u);
            else XB_SPIN(xb_ld(&bar[XB_TOPGEN]) == tg, bar);
            __builtin_amdgcn_fence(__ATOMIC_ACQUIRE, "agent");
            xb_add(&bar[XB_XGEN(b.x)], 1u);
            asm volatile("s_waitcnt vmcnt(0)" ::: "memory");
        } else {
            XB_SPIN(xb_ld(&bar[XB_XGEN(b.x)]) == gen, bar);
            __builtin_amdgcn_fence(__ATOMIC_ACQUIRE, "agent");
            asm volatile("s_waitcnt vmcnt(0)" ::: "memory");
        }
    }
    __syncthreads();
}


constexpr int N_PHASES = 24;
#define EN(n) (ONLYP < 0 || ONLYP == (n))
template <int ONLYP> __global__ void __launch_bounds__(NTHR) fwd_megakernel(Params p) {
    extern __shared__ __attribute__((aligned(16))) unsigned char lds[];
    cg::grid_group grid = cg::this_grid();
    unsigned char* ws = p.ws;
    bf16_t* UY = (bf16_t*)(ws + WS_UY); bf16_t* BIG = (bf16_t*)(ws + WS_BIG);
    bf16_t* Pb = (bf16_t*)(ws + WS_BIG + BIG_P); bf16_t* CV = (bf16_t*)(ws + WS_BIG + BIG_CV);
    bf16_t* Gb = (bf16_t*)(ws + WS_BIG + BIG_G); bf16_t* Ub = (bf16_t*)(ws + WS_BIG + BIG_U);
    float* hc = (float*)(ws + WS_HC); float* mods = (float*)(ws + WS_MODS); float* gates = (float*)(ws + WS_GATES);
    const float* m0 = mods; const float* m1 = mods + 9 * 6144;
    const int lo = p.ph_lo, hi = p.ph_hi;
    volatile LAS unsigned* xb_st = (volatile LAS unsigned*)(LAS unsigned char*)(lds + LDS_BYTES);
    if (threadIdx.x < 4) xb_st[threadIdx.x] = 0u;
    if (blockIdx.x == 0) for (int i = threadIdx.x; i < XCD_BAR_WORDS; i += NTHR) ((unsigned*)(ws + WS_BAR))[i] = 0u;
    __syncthreads();
    XcdBarrier xb; xb.bar = (unsigned*)(ws + WS_BAR); xb.x = 0; xb.st = xb_st;
#ifndef DUPMASK
#define DUPMASK 0u
#endif
#define PH(k) if (EN(k) && lo <= (k) && (k) < hi) for (int rep_ = 0; rep_ <= (int)((DUPMASK >> (k)) & 1u); ++rep_) if (rep_ == 0 || (grid.sync(), true))
#define SEAM(k) if (lo <= (k) && (k) + 1 < hi) { if ((k) == 0) { grid.sync(); xb = xcd_barrier_post((unsigned*)(ws + WS_BAR), xb_st); } else xcd_barrier(xb); }
    PH(0) { phase_prep(p, lds); }
    SEAM(0)
    PH(1) { { RNArgs a{p.x, p.ctx, nullptr, nullptr, nullptr, nullptr, nullptr, p.norm_g + 0 * D, m0 + 0 * D, m0 + 1 * D, UY, p.ev_w_in + NP0, 2320, gates, MT, 0}; phase_rownorm(a, lds); } }
    SEAM(1)
    PH(2) { run_gemm(lds, UY, (const bf16_t*)(ws + WS_WT_IN0), MT, NP0, D, Pb, NP0, 0, 0); }
    SEAM(2)
    PH(3) { rope_pass(lds, Pb, NP0, 8, 2); conv5_pass(lds, Pb, NP0, 768, 512, p.b_conv, nullptr, 256, CV); }
    SEAM(3)
    PH(4) { for (int it = bidx(); it < 1088 + 2176; it += gridDim.x) { if (it < 1088) gqa_item(p, lds, it); else mlstm_local_item(p, lds, it - 1088); } }
    SEAM(4)
    PH(5) { mlstm_scan(p, lds); }
    SEAM(5)
    PH(6) { for (int it = bidx(); it < 2176; it += gridDim.x) mlstm_out_item(p, lds, it); }
    SEAM(6)
    PH(7) { run_gemm(lds, UY, (const bf16_t*)(ws + WS_WT_OUT0), MT, D, D, BIG, D, 0, 0); }
    SEAM(7)
    PH(8) { { RNArgs a{p.x, p.ctx, BIG, p.norm_g + 1 * D, m0 + 2 * D, p.out, hc, p.norm_g + 2 * D, m0 + 3 * D, m0 + 4 * D, UY, nullptr, 0, nullptr, MT, 0}; phase_rownorm(a, lds); } }
    SEAM(8)
    PH(9) { run_gemm_act(lds, UY, (const bf16_t*)(ws + WS_WT_GU0), MT, Gb, p.ffn_conv); }
    SEAM(9)
    PH(11) { run_gemm(lds, Gb, (const bf16_t*)(ws + WS_WT_DN0), ML, D, FH, UY, D, 0, 0); }
    SEAM(11)
    PH(12) { RNArgs a{p.out, hc, UY, p.norm_g + 3 * D, m0 + 5 * D, p.out, hc, p.norm_g + 4 * D, m1 + 0 * D, m1 + 1 * D, UY, p.od_w_in + NP1, 3088, gates, ML, 0};
        const int nb = (int)gridDim.x, bb = (int)bidx();
        if (nb >= 64) { if (bb < 32) run_gemm(lds, Gb + (size_t)ML * FH, (const bf16_t*)(ws + WS_WT_DN0), MC, D, FH, UY + (size_t)ML * D, D, 0, 0, 32, bb); else phase_rownorm(a, lds, bb - 32, nb - 32); }
        else { run_gemm(lds, Gb + (size_t)ML * FH, (const bf16_t*)(ws + WS_WT_DN0), MC, D, FH, UY + (size_t)ML * D, D, 0, 0); __syncthreads(); phase_rownorm(a, lds); }
        if (lo <= 12 && 13 < hi) xcd_barrier(xb);
        RNArgs a2 = a; a2.nrows = MC; a2.row_begin = ML; phase_rownorm(a2, lds); }
    SEAM(12)
    PH(13) { run_gemm_in1(lds, UY, (const bf16_t*)(ws + WS_WT_IN1), Pb, CV, p.d_conv, p.d_conv_b); }
    SEAM(13)
    PH(14) { rope_pass(lds, Pb, NP1, 8, 8); vt_pass(p, lds); }
    SEAM(14)
    PH(15) { {
            const float lam_init = 0.8f - 0.6f * 0.7408182206817179f;
            float lam;
            { const int lane = tidx() & 63; float s1 = p.c_lambda[lane] * p.c_lambda[64 + lane], s2 = p.c_lambda[128 + lane] * p.c_lambda[192 + lane];
              s1 = wave_sum(s1); s2 = wave_sum(s2); lam = expf(s1) - expf(s2) + lam_init; }
            for (int it = bidx(); it < 512 + 1088; it += gridDim.x) {
                if (it < 512) { int item = it;
                    if (gridDim.x == 256) { const int rd = it >> 8, c = it & 255, x = c & 7, sl = c >> 3; item = ((rd * 16 + x * 2 + (sl >> 4)) << 4) | (sl & 15); }
                    diff_item(p, lds, item, lam, lam_init); }
                else ssd_local_item(p, lds, it - 512); }
        } }
    SEAM(15)
    PH(16) { ssd_scan(p, lds); }
    SEAM(16)
    PH(17) { for (int it = bidx(); it < 512; it += gridDim.x) ssd_out_item(p, lds, it); }
    SEAM(17)
    PH(18) { run_gemm(lds, UY, (const bf16_t*)(ws + WS_WT_OUT1), ML, D, D, BIG, D, 0, 0); }
    SEAM(18)
    PH(19) { { RNArgs a{p.out, hc, BIG, p.norm_g + 5 * D, m1 + 2 * D, p.out, hc, p.norm_g + 6 * D, m1 + 3 * D, m1 + 4 * D, UY, nullptr, 0, nullptr, ML, 0}; phase_rownorm(a, lds); } }
    SEAM(19)
    PH(20) { run_gemm_act(lds, UY, (const bf16_t*)(ws + WS_WT_GU1), ML, Gb, p.ffn_conv + 3 * FH); }
    SEAM(20)
    PH(22) { run_gemm(lds, Gb, (const bf16_t*)(ws + WS_WT_DN1), ML, D, FH, UY, D, 0, 0); }
    SEAM(22)
#ifdef EXTRA_SYNCS
    for (int q_ = 0; q_ < EXTRA_SYNCS; ++q_) grid.sync();
#endif
    PH(23) { { RNArgs a{p.out, hc, UY, p.norm_g + 7 * D, m1 + 5 * D, p.out, hc, nullptr, nullptr, nullptr, nullptr, nullptr, 0, nullptr, ML, 0}; phase_rownorm(a, lds); } }
    SEAM(23)
}

#ifndef MULTI_LAUNCH
#define MULTI_LAUNCH 0
#endif
template <int K> static void launch_phase(Params p, int grid, hipStream_t stream) {
    p.ph_lo = K; p.ph_hi = K + 1;
    static bool attr = false;
    if (!attr) { (void)hipFuncSetAttribute((const void*)fwd_megakernel<K>, hipFuncAttributeMaxDynamicSharedMemorySize, LDS_TOTAL); attr = true; }
    hipLaunchKernelGGL(fwd_megakernel<K>, dim3(grid), dim3(NTHR), LDS_TOTAL, stream, p);
}
template <int K> static void launch_all(const Params& p, int grid, hipStream_t stream) {
    if constexpr (K < N_PHASES) { launch_phase<K>(p, grid, stream); launch_all<K + 1>(p, grid, stream); }
}
extern "C" void kernel_launch(void* const* d_in, const int* in_sizes, int n_in, void* d_out, int out_size, void* d_ws, size_t ws_size, hipStream_t stream) {
    static int grid_blocks = 0;
    if (!grid_blocks) {
        int dev = 0, cus = 0;
        hipGetDevice(&dev);
        hipDeviceGetAttribute(&cus, hipDeviceAttributeMultiprocessorCount, dev);
        grid_blocks = cus;
        if (ws_size < WS_END) fprintf(stderr, "workspace too small: %zu < %zu\n", ws_size, (size_t)WS_END);
    }
    Params p{};
    const float** pp = (const float**)&p;
    for (int i = 0; i < 27; ++i) pp[i] = (const float*)d_in[i];
    p.out = (float*)d_out; p.ws = (unsigned char*)d_ws; p.ph_lo = 0; p.ph_hi = N_PHASES;
#if MULTI_LAUNCH
    launch_all<0>(p, grid_blocks, stream);
#else
    static bool attr = false;
    if (!attr) {
        int per_cu = 0;
        if (hipFuncSetAttribute((const void*)fwd_megakernel<-1>, hipFuncAttributeMaxDynamicSharedMemorySize, LDS_TOTAL) != hipSuccess) fprintf(stderr, "hipFuncSetAttribute failed\n");
        hipOccupancyMaxActiveBlocksPerMultiprocessor(&per_cu, (const void*)fwd_megakernel<-1>, NTHR, LDS_TOTAL);
        if (per_cu < 1) fprintf(stderr, "occupancy query says %d\n", per_cu);
        attr = true;
    }
    void* args[] = {&p};
    hipError_t e = hipLaunchCooperativeKernel((void*)fwd_megakernel<-1>, dim3(grid_blocks), dim3(NTHR), args, LDS_TOTAL, stream);
    if (e != hipSuccess) fprintf(stderr, "cooperative launch failed: %s (grid %d)\n", hipGetErrorString(e), grid_blocks);
#endif
}
```

```cpp
#include <hip/hip_runtime.h>
#include <hip/hip_cooperative_groups.h>
#include <cstdio>
namespace cg = cooperative_groups;

#define DI __device__ __forceinline__
#define LAS __attribute__((address_space(3)))
typedef unsigned short bf16_t;
typedef short bf16x8 __attribute__((ext_vector_type(8)));
typedef short s16x4 __attribute__((ext_vector_type(4)));
typedef float f32x4 __attribute__((ext_vector_type(4)));
typedef float f32x2 __attribute__((ext_vector_type(2)));
typedef float f32x16 __attribute__((ext_vector_type(16)));
typedef unsigned u32x4 __attribute__((ext_vector_type(4)));
typedef unsigned u32x2 __attribute__((ext_vector_type(2)));
typedef __bf16 bfv2 __attribute__((ext_vector_type(2)));

constexpr int D = 1024, NB = 8, T = 4096, CT = 256;
constexpr int ML = NB * T, MC = NB * CT, MT = ML + MC;
constexpr int NP0 = 2304, NP1 = 3072, FH = 2816;
constexpr float EPS = 1e-6f;
constexpr float LOG2E = 1.4426950408889634f;
constexpr float QSCALE = 0.125f * LOG2E;
constexpr int NTHR = 512;
constexpr int LDS_BYTES = 148480;
constexpr int LDS_TOTAL = LDS_BYTES + 256;

constexpr size_t al256(size_t x) { return (x + 255) & ~(size_t)255; }
constexpr size_t WS_WT_IN0 = 0;
constexpr size_t WS_WT_IN1 = WS_WT_IN0 + (size_t)NP0 * D * 2;
constexpr size_t WS_WT_OUT0 = WS_WT_IN1 + (size_t)NP1 * D * 2;
constexpr size_t WS_WT_OUT1 = WS_WT_OUT0 + (size_t)D * D * 2;
constexpr size_t WS_WT_GU0 = WS_WT_OUT1 + (size_t)D * D * 2;
constexpr size_t WS_WT_GU1 = WS_WT_GU0 + (size_t)2 * FH * D * 2;
constexpr size_t WS_WT_DN0 = WS_WT_GU1 + (size_t)2 * FH * D * 2;
constexpr size_t WS_WT_DN1 = WS_WT_DN0 + (size_t)D * FH * 2;
constexpr size_t WS_HC = WS_WT_DN1 + (size_t)D * FH * 2;
constexpr size_t WS_MODS = WS_HC + (size_t)MC * D * 4;
constexpr size_t WS_GATES = al256(WS_MODS + (size_t)2 * 9 * 6144 * 4);
constexpr size_t WS_SC = al256(WS_GATES + (size_t)MT * 16 * 4);
constexpr size_t WS_NS = al256(WS_SC + (size_t)4352 * 8 * 4);
constexpr size_t WS_BAR = al256(WS_NS + (size_t)4352 * 64 * 4);
constexpr size_t WS_ROPE = al256(WS_BAR + (size_t)4096 * 4);
constexpr size_t WS_UY = al256(WS_ROPE + 8192 + 4096);
constexpr size_t WS_BIG = al256(WS_UY + (size_t)MT * D * 2);
constexpr size_t BIG_P = 0;
constexpr size_t BIG_ST = (size_t)MT * NP1 * 2;
constexpr size_t BIG_CV = BIG_ST + (size_t)4352 * 8192 * 2;
constexpr size_t BIG_VT = BIG_CV + (size_t)MT * 1024 * 2;
constexpr size_t BIG_G = 0;
constexpr size_t BIG_U = (size_t)MT * FH * 2;
constexpr size_t WS_END = WS_BIG + 2 * (size_t)MT * FH * 2;
static_assert(BIG_VT + (size_t)32 * 128 * 4352 * 2 <= 2 * (size_t)MT * FH * 2, "mixer scratch fits");
static_assert(WS_END <= (size_t)536870912, "workspace");

struct Params {
    const float *x, *c, *ctx, *c_ctx, *mod_w, *mod_b, *norm_g, *ffn_w_gate, *ffn_w_up, *ffn_conv, *ffn_w_down,
        *ev_w_in, *ev_w_out, *a_sink, *b_conv, *b_gate_b, *b_norm_g, *od_w_in, *od_w_out, *c_lambda,
        *c_norm_g, *d_conv, *d_conv_b, *d_dt_bias, *d_a_log, *d_skip, *d_norm_g;
    float* out; unsigned char* ws; int ph_lo, ph_hi;
};

DI int tidx() { int t = threadIdx.x; asm volatile("" : "+v"(t)); return t; }
DI int bidx() { int t = blockIdx.x; asm volatile("" : "+s"(t)); return t; }
DI float bf2f(bf16_t b) { return __uint_as_float(((unsigned)b) << 16); }
DI unsigned pk2(float lo, float hi) { f32x2 v = {lo, hi}; bfv2 b = __builtin_convertvector(v, bfv2); return __builtin_bit_cast(unsigned, b); }
DI bf16_t f2bf(float f) { return (bf16_t)(pk2(f, 0.f) & 0xffffu); }
DI float lo16(unsigned u) { return __uint_as_float(u << 16); }
DI float hi16(unsigned u) { return __uint_as_float(u & 0xffff0000u); }
DI float silu_f(float v) { return v * __builtin_amdgcn_rcpf(1.f + __expf(-v)); }
DI float sigmoid_f(float v) { return __builtin_amdgcn_rcpf(1.f + __expf(-v)); }
DI float wave_sum(float v) {
#pragma unroll
    for (int o = 32; o >= 1; o >>= 1) v += __shfl_xor(v, o);
    return v;
}
DI float wave_scan_add(float v, int lane) {
#pragma unroll
    for (int o = 1; o < 64; o <<= 1) { const float t = __shfl_up(v, o); if (lane >= o) v += t; }
    return v;
}
DI float wave_scan_max(float v, int lane) {
#pragma unroll
    for (int o = 1; o < 64; o <<= 1) { const float t = __shfl_up(v, o); if (lane >= o) v = fmaxf(v, t); }
    return v;
}
DI float wave_max(float v) {
#pragma unroll
    for (int o = 32; o >= 1; o >>= 1) v = fmaxf(v, __shfl_xor(v, o));
    return v;
}
DI float xor32(float v, int h) {
    const unsigned u = __builtin_bit_cast(unsigned, v);
    const auto r = __builtin_amdgcn_permlane32_swap(u, u, false, false);
    return __builtin_bit_cast(float, h ? r[0] : r[1]);
}
DI int crow(int i, int h) { return (i & 3) + 8 * (i >> 2) + 4 * h; }
#define MFMA32(a, b, c) __builtin_amdgcn_mfma_f32_32x32x16_bf16((a), (b), (c), 0, 0, 0)
DI bf16x8 pack8(const f32x16& x, int s) {
    u32x4 p;
    p.x = pk2(x[8 * s + 0], x[8 * s + 1]); p.y = pk2(x[8 * s + 2], x[8 * s + 3]);
    p.z = pk2(x[8 * s + 4], x[8 * s + 5]); p.w = pk2(x[8 * s + 6], x[8 * s + 7]);
    return __builtin_bit_cast(bf16x8, p);
}
DI bf16x8 ld_tr2(const bf16_t* p) {
    s16x4 lo = *(const s16x4*)p, hi = *(const s16x4*)(p + 8);
    return __builtin_shufflevector(lo, hi, 0, 1, 2, 3, 4, 5, 6, 7);
}
DI f32x16 zero16() { f32x16 z; for (int i = 0; i < 16; ++i) z[i] = 0.f; return z; }

namespace pg8 {
constexpr int BM = 256, BK = 64, HALF = 128, HTB = HALF * BK * 2, STAGE_BYTES = 8 * HTB, NXCD = 8, WGM = 8;
DI int lds_byte(int r, int c) { const int st = (r >> 4) * 2 + (c >> 5), rr = r & 15, cc = c & 31, ob = rr * 64 + cc * 2; return st * 1024 + (ob ^ (((ob >> 9) & 1) << 5)); }
DI void stage_rc(int b, int& R, int& C) { const int st = b / 1024, sb = b % 1024, swz = sb ^ (((sb >> 9) & 1) << 5); R = (st >> 1) * 16 + swz / 64; C = (st & 1) * 32 + (swz % 64) / 2; }
DI int perm32(int rho) { const int n = rho >> 4, i = rho & 15; return 8 * (i >> 2) + 4 * n + (i & 3); }
struct Unit { int pm, pn; };
struct Gemm { const bf16_t* A; const bf16_t* Bt; int M, N, K; int conv; };
struct StaticOrder {
    int nM, nN, nwg, G, c;
    DI void init(int M, int N, int G_, int c_) { nM = M / BM; nN = N / BM; nwg = nM * nN; G = G_; c = c_; }
    DI void init_tiles(int nM_, int nN_, int G_, int c_) { nM = nM_; nN = nN_; nwg = nM * nN; G = G_; c = c_; }
    DI bool next(int i, Unit& u) const {
        const long L = (long)i * G + c; if (L >= nwg) return false;
        int wgid = (int)L; { const int q = nwg / NXCD, r = nwg % NXCD, xcd = wgid % NXCD, off = wgid / NXCD; wgid = (xcd < r ? xcd * (q + 1) : r * (q + 1) + (xcd - r) * q) + off; }
        const int nig = WGM * nN, gid = wgid / nig, fm = gid * WGM, gsz = (nM - fm) < WGM ? (nM - fm) : WGM;
        u.pm = fm + ((wgid % nig) % gsz); u.pn = (wgid % nig) / gsz; return true;
    }
};
struct EpiBf {
    bf16_t* O; int ldc; int split_cols; size_t split_stride;
    DI void operator()(const f32x4 (&acc)[2][2][4][2], const Unit& u, int wr, int wc, int fr, int fq) const {
        const int row0 = u.pm * BM + wr * 64 + fr; int colt = u.pn * BM; bf16_t* base = O;
        if (split_cols) { const int t = colt / split_cols; base += (size_t)t * split_stride; colt -= t * split_cols; }
        const int col0 = colt + wc * 32 + 8 * fq;
#pragma unroll
        for (int ai = 0; ai < 2; ++ai)
#pragma unroll
            for (int m = 0; m < 4; ++m) { bf16_t* rowp = base + (size_t)(row0 + ai * HALF + m * 16) * ldc + col0;
#pragma unroll
                for (int bj = 0; bj < 2; ++bj) { const f32x4 v0 = acc[ai][bj][m][0], v1 = acc[ai][bj][m][1];
                    u32x4 w; w.x = pk2(v0[0], v0[1]); w.y = pk2(v0[2], v0[3]); w.z = pk2(v1[0], v1[1]); w.w = pk2(v1[2], v1[3]);
                    *(u32x4*)(rowp + bj * HALF) = w; } }
    }
};
DI float dpp_ror1(float v) { return __builtin_bit_cast(float, __builtin_amdgcn_mov_dpp(__builtin_bit_cast(int, v), 0x121, 0xf, 0xf, false)); }
DI float dpp_ror15(float v) { return __builtin_bit_cast(float, __builtin_amdgcn_mov_dpp(__builtin_bit_cast(int, v), 0x12f, 0xf, 0xf, false)); }
DI float nb_up1(float cur, float prv) { return __builtin_bit_cast(float, __builtin_amdgcn_update_dpp(__builtin_bit_cast(int, dpp_ror1(prv)), __builtin_bit_cast(int, cur), 0x111, 0xf, 0xf, false)); }
DI float nb_dn1(float cur, float nxt) { return __builtin_bit_cast(float, __builtin_amdgcn_update_dpp(__builtin_bit_cast(int, dpp_ror15(nxt)), __builtin_bit_cast(int, cur), 0x101, 0xf, 0xf, false)); }
struct EpiAct {
    bf16_t* H; const bf16_t* cw; int nrows;
    DI void operator()(const f32x4 (&acc)[2][2][4][2], const Unit& u, int wr, int wc, int fr, int fq) const {
        const int gcol = u.pn * 128 + wc * 32 + 8 * fq;
        f32x4 w0[2], w1[2], w2[2];
#pragma unroll
        for (int n = 0; n < 2; ++n) { const u32x2 t0 = *(const u32x2*)(cw + gcol + 4 * n), t1 = *(const u32x2*)(cw + FH + gcol + 4 * n), t2 = *(const u32x2*)(cw + 2 * FH + gcol + 4 * n);
            w0[n] = (f32x4){lo16(t0.x), hi16(t0.x), lo16(t0.y), hi16(t0.y)}; w1[n] = (f32x4){lo16(t1.x), hi16(t1.x), lo16(t1.y), hi16(t1.y)}; w2[n] = (f32x4){lo16(t2.x), hi16(t2.x), lo16(t2.y), hi16(t2.y)}; }
#pragma unroll
        for (int ai = 0; ai < 2; ++ai)
#pragma unroll
            for (int m = 0; m < 4; ++m) {
                const int inb = 16 * m + fr, row = u.pm * 248 + (ai * 2 + wr) * 62 + inb - 1;
                int t, len; if (row < ML) { t = row & (T - 1); len = T; } else { t = (row - ML) & (CT - 1); len = CT; }
                const bool has_up = t > 0, has_dn = t < len - 1, st = inb >= 1 && inb <= 62 && row < nrows;
                f32x4 hv[2];
#pragma unroll
                for (int n = 0; n < 2; ++n) { const f32x4 g = acc[ai][0][m][n], gp = acc[ai][0][m > 0 ? m - 1 : 0][n], gn = acc[ai][0][m < 3 ? m + 1 : 3][n];
                    f32x4 wu, wd;
#pragma unroll
                    for (int j = 0; j < 4; ++j) { wu[j] = has_up ? w0[n][j] : 0.f; wd[j] = has_dn ? w2[n][j] : 0.f; }
#pragma unroll
                    for (int j = 0; j < 4; ++j) { const float up = nb_up1(g[j], gp[j]), dn = nb_dn1(g[j], gn[j]);
                        const float cv = fmaf(wu[j], up, fmaf(wd[j], dn, w1[n][j] * g[j]));
                        hv[n][j] = silu_f(cv) * acc[ai][1][m][n][j]; } }
                if (st) { u32x4 w; w.x = pk2(hv[0][0], hv[0][1]); w.y = pk2(hv[0][2], hv[0][3]); w.z = pk2(hv[1][0], hv[1][1]); w.w = pk2(hv[1][2], hv[1][3]);
                    *(u32x4*)(H + (size_t)row * FH + gcol) = w; }
            }
    }
};
DI float nb_up2(float cur, float prv) { const int o = __builtin_amdgcn_mov_dpp(__builtin_bit_cast(int, prv), 0x122, 0xf, 0xf, false);
    return __builtin_bit_cast(float, __builtin_amdgcn_update_dpp(o, __builtin_bit_cast(int, cur), 0x112, 0xf, 0xf, false)); }
DI float nb_dn2(float cur, float nxt) { const int o = __builtin_amdgcn_mov_dpp(__builtin_bit_cast(int, nxt), 0x12e, 0xf, 0xf, false);
    return __builtin_bit_cast(float, __builtin_amdgcn_update_dpp(o, __builtin_bit_cast(int, cur), 0x102, 0xf, 0xf, false)); }
struct EpiConv5 {
    bf16_t* P; bf16_t* X; const bf16_t* cw; const bf16_t* cb; int nrows;
    DI void operator()(const f32x4 (&acc)[2][2][4][2], const Unit& u, int wr, int wc, int fr, int fq) const { half<0>(acc, u, wr, wc, fr, fq); half<1>(acc, u, wr, wc, fr, fq); }
    template <int AI> DI void half(const f32x4 (&acc)[2][2][4][2], const Unit& u, int wr_, int wc_, int fr_, int fq_) const {
        constexpr int ai = AI;
        const int tid_ = tidx(), wid_ = __builtin_amdgcn_readfirstlane(tid_ >> 6), wr = wid_ >> 2, wc = wid_ & 3, fr = tid_ & 15, fq = (tid_ & 63) >> 4;
        if (u.pn < 8) {
            const int col0 = u.pn * 256 + wc * 32 + 8 * fq;
#pragma unroll
            for (int m = 0; m < 4; ++m) { const int inb = 16 * m + fr, row = u.pm * 240 + (ai * 2 + wr) * 60 + inb - 2;
                if (inb >= 2 && inb <= 61 && row < nrows) {
#pragma unroll
                    for (int bj = 0; bj < 2; ++bj) { const f32x4 v0 = acc[ai][bj][m][0], v1 = acc[ai][bj][m][1];
                        u32x4 w; w.x = pk2(v0[0], v0[1]); w.y = pk2(v0[2], v0[3]); w.z = pk2(v1[0], v1[1]); w.w = pk2(v1[2], v1[3]);
                        *(u32x4*)(P + (size_t)row * NP1 + col0 + bj * HALF) = w; } } }
        } else {
#pragma unroll
            for (int bj = 0; bj < 2; ++bj)
#pragma unroll
                for (int n = 0; n < 2; ++n) {
                    const int gcol = (u.pn - 8) * 256 + bj * HALF + wc * 32 + 8 * fq + 4 * n;
                    f32x4 w[5];
                    const u32x2 tb = *(const u32x2*)(cb + gcol);
                    const f32x4 bs = (f32x4){lo16(tb.x), hi16(tb.x), lo16(tb.y), hi16(tb.y)};
#pragma unroll
                    for (int j = 0; j < 5; ++j) { const u32x2 tw = *(const u32x2*)(cw + j * 1024 + gcol); w[j] = (f32x4){lo16(tw.x), hi16(tw.x), lo16(tw.y), hi16(tw.y)}; }
#pragma unroll
                    for (int m = 0; m < 4; ++m) {
                        const int inb = 16 * m + fr, row = u.pm * 240 + (ai * 2 + wr) * 60 + inb - 2;
                        int t, len; if (row < ML) { t = row & (T - 1); len = T; } else { t = (row - ML) & (CT - 1); len = CT; }
                        const bool st = inb >= 2 && inb <= 61 && row < nrows;
                        const f32x4 g = acc[ai][bj][m][n], gp = acc[ai][bj][m > 0 ? m - 1 : 0][n], gn = acc[ai][bj][m < 3 ? m + 1 : 3][n];
                        float hv[4];
                        const bool m0 = t >= 2, m1 = t >= 1, m3 = t <= len - 2, m4 = t <= len - 3;
#pragma unroll
                        for (int j = 0; j < 4; ++j) {
                            const float up1 = nb_up1(g[j], gp[j]), up2 = nb_up2(g[j], gp[j]), dn1 = nb_dn1(g[j], gn[j]), dn2 = nb_dn2(g[j], gn[j]);
                            float cv = fmaf(w[2][j], g[j], bs[j]);
                            cv = fmaf(m1 ? w[1][j] : 0.f, up1, cv); cv = fmaf(m0 ? w[0][j] : 0.f, up2, cv);
                            cv = fmaf(m3 ? w[3][j] : 0.f, dn1, cv); cv = fmaf(m4 ? w[4][j] : 0.f, dn2, cv);
                            hv[j] = silu_f(cv); }
                        if (st) { u32x2 wv; wv.x = pk2(hv[0], hv[1]); wv.y = pk2(hv[2], hv[3]); *(u32x2*)(X + (size_t)row * 1024 + gcol) = wv; }
                        __builtin_amdgcn_sched_barrier(0);
                    }
                    __builtin_amdgcn_sched_barrier(0);
                }
        }
    }
};
template <class Epi, class Sched>
DI void gemm_phase(LAS unsigned char* lds, const Gemm g, const Sched& S, const Epi& E) {
    const int tid = tidx(), wid = __builtin_amdgcn_readfirstlane(tid >> 6), lane = tid & 63, wr = wid >> 2, wc = wid & 3, fr = lane & 15, fq = lane >> 4;
    const int K = g.K, nt = K / BK;
    unsigned voffA[2], voffB[2];
#pragma unroll
    for (int i = 0; i < 2; ++i) { int R, C; stage_rc(tid * 16 + i * 8192, R, C); const int Rb = (R & ~31) + perm32(R & 31);
        const int Ra = g.conv ? ((R >> 6) * g.conv + (R & 63)) : R;
        voffA[i] = (unsigned)(Ra * K + C) * 2u; voffB[i] = (unsigned)(Rb * K + C) * 2u; }
    const size_t kstep = (size_t)(BK * 2);
    const size_t hstep = (size_t)HALF * K * 2;
    const size_t tstep = 2 * hstep;
    const size_t hstepA = g.conv ? (size_t)(2 * g.conv) * K * 2 : hstep, tstepA = 2 * hstepA;
    const unsigned ldsw = (unsigned)wid * 1024u;
    const int aoff = lds_byte(wr * 64 + fr, fq * 8), boff = lds_byte(wc * 32 + fr, fq * 8);
#define PG8_SA(b, h) (((b) * 2 + (h)) * HTB)
#define PG8_SB(b, h) ((4 + (b) * 2 + (h)) * HTB)
#define PG8_STAGE(bufoff, gbase, voff) do { _Pragma("unroll") for (int _i = 0; _i < 2; ++_i) \
        __builtin_amdgcn_global_load_lds((const unsigned*)((const char*)(gbase) + (voff)[_i]), (LAS unsigned*)(lds + (bufoff) + ldsw + _i * 8192), 16, 0, 0); } while (0)
#define PG8_LDA(dst, b, h) do { _Pragma("unroll") for (int m = 0; m < 4; ++m) _Pragma("unroll") for (int k = 0; k < 2; ++k) dst[m][k] = *(const LAS bf16x8*)(lds + PG8_SA(b, h) + aoff + m * 2048 + k * 1024); } while (0)
#define PG8_LDB(dst, b, h) do { _Pragma("unroll") for (int n = 0; n < 2; ++n) _Pragma("unroll") for (int k = 0; k < 2; ++k) dst[n][k] = *(const LAS bf16x8*)(lds + PG8_SB(b, h) + boff + n * 2048 + k * 1024); } while (0)
#define PG8_MMA(ai, bj, At, Bt) do { __builtin_amdgcn_s_setprio(1); _Pragma("unroll") for (int m = 0; m < 4; ++m) _Pragma("unroll") for (int n = 0; n < 2; ++n) _Pragma("unroll") for (int k = 0; k < 2; ++k) \
        acc[ai][bj][m][n] = __builtin_amdgcn_mfma_f32_16x16x32_bf16(Bt[n][k], At[m][k], acc[ai][bj][m][n], 0, 0, 0); __builtin_amdgcn_s_setprio(0); } while (0)
#define PG8_WAIT_V(n) asm volatile("s_waitcnt vmcnt(" #n ")" ::: "memory")
#define PG8_WAIT_L(n) asm volatile("s_waitcnt lgkmcnt(" #n ")" ::: "memory")
#define PG8_BAR __builtin_amdgcn_s_barrier()
#define PG8_SCHED __builtin_amdgcn_sched_barrier(0)
    Unit cur, nxt; int ui = 0;
    if (!S.next(0, cur)) return;
    f32x4 acc[2][2][4][2];
#pragma unroll
    for (int a = 0; a < 2; ++a)
#pragma unroll
        for (int b = 0; b < 2; ++b)
#pragma unroll
            for (int m = 0; m < 4; ++m)
#pragma unroll
                for (int n = 0; n < 2; ++n) acc[a][b][m][n] = (f32x4){0.f, 0.f, 0.f, 0.f};
    bf16x8 At[4][2], B0[2][2], B1[2][2];
    const char* cA = (const char*)g.A + (size_t)cur.pm * tstepA; const char* cB = (const char*)g.Bt + (size_t)cur.pn * tstep;
    PG8_STAGE(PG8_SB(0, 0), cB, voffB); PG8_STAGE(PG8_SA(0, 0), cA, voffA); PG8_STAGE(PG8_SB(0, 1), cB + hstep, voffB); PG8_STAGE(PG8_SA(0, 1), cA + hstepA, voffA);
    if (wr == 1) PG8_BAR;
    PG8_WAIT_V(4); PG8_BAR;
    PG8_STAGE(PG8_SB(1, 0), cB + kstep, voffB); PG8_STAGE(PG8_SA(1, 0), cA + kstep, voffA); PG8_STAGE(PG8_SB(1, 1), cB + hstep + kstep, voffB);
    PG8_WAIT_V(6); PG8_BAR;
    for (;;) {
        const bool has_next = S.next(ui + 1, nxt);
        const char* nA = has_next ? (const char*)g.A + (size_t)nxt.pm * tstepA : cA; const char* nB = has_next ? (const char*)g.Bt + (size_t)nxt.pn * tstep : cB;
        for (int t = 0; t < nt; t += 2) {
            const bool last = (t == nt - 2);
            const char* a1 = cA + (size_t)(t + 1) * kstep;
            const char* a2 = last ? nA : cA + (size_t)(t + 2) * kstep; const char* b2 = last ? nB : cB + (size_t)(t + 2) * kstep;
            const char* a3 = a2 + kstep; const char* b3 = b2 + kstep;
            PG8_LDB(B0, 0, 0); PG8_SCHED; PG8_LDA(At, 0, 0); PG8_STAGE(PG8_SA(1, 1), a1 + hstepA, voffA);
            PG8_WAIT_L(8); PG8_BAR; PG8_WAIT_L(0); PG8_MMA(0, 0, At, B0); PG8_BAR; PG8_SCHED;
            PG8_LDB(B1, 0, 1); PG8_STAGE(PG8_SB(0, 0), b2, voffB);
            PG8_BAR; PG8_WAIT_L(0); PG8_MMA(0, 1, At, B1); PG8_BAR;
            PG8_LDA(At, 0, 1); PG8_STAGE(PG8_SA(0, 0), a2, voffA);
            PG8_BAR; PG8_WAIT_L(0); PG8_MMA(1, 0, At, B0); PG8_BAR; PG8_SCHED;
            PG8_STAGE(PG8_SB(0, 1), b2 + hstep, voffB);
            PG8_WAIT_V(6); PG8_BAR; PG8_MMA(1, 1, At, B1); PG8_BAR;
            PG8_LDB(B0, 1, 0); PG8_SCHED; PG8_LDA(At, 1, 0); PG8_STAGE(PG8_SA(0, 1), a2 + hstepA, voffA);
            PG8_WAIT_L(8); PG8_BAR; PG8_WAIT_L(0); PG8_MMA(0, 0, At, B0); PG8_BAR; PG8_SCHED;
            PG8_LDB(B1, 1, 1); PG8_STAGE(PG8_SB(1, 0), b3, voffB);
            PG8_BAR; PG8_WAIT_L(0); PG8_MMA(0, 1, At, B1); PG8_BAR;
            PG8_LDA(At, 1, 1); PG8_STAGE(PG8_SA(1, 0), a3, voffA);
            PG8_BAR; PG8_WAIT_L(0); PG8_MMA(1, 0, At, B0); PG8_BAR; PG8_SCHED;
            PG8_STAGE(PG8_SB(1, 1), b3 + hstep, voffB);
            PG8_WAIT_V(6); PG8_BAR; PG8_MMA(1, 1, At, B1); PG8_BAR;
        }
        E(acc, cur, wr, wc, fr, fq);
        if (!has_next) break;
#pragma unroll
        for (int a = 0; a < 2; ++a)
#pragma unroll
            for (int b = 0; b < 2; ++b)
#pragma unroll
                for (int m = 0; m < 4; ++m)
#pragma unroll
                    for (int n = 0; n < 2; ++n) acc[a][b][m][n] = (f32x4){0.f, 0.f, 0.f, 0.f};
        cur = nxt; cA = nA; cB = nB; ++ui;
    }
    PG8_WAIT_V(0);
    if (wr == 0) PG8_BAR;
    PG8_BAR;
#undef PG8_SA
#undef PG8_SB
#undef PG8_STAGE
#undef PG8_LDA
#undef PG8_LDB
#undef PG8_MMA
#undef PG8_WAIT_V
#undef PG8_WAIT_L
#undef PG8_BAR
#undef PG8_SCHED
}
}

DI void run_gemm(unsigned char* lds, const bf16_t* A, const bf16_t* Bt, int M, int N, int K, bf16_t* O, int ldc, int split_cols, size_t split_stride, int G = 0, int c = 0) {
    asm volatile("" : "+s"(M), "+s"(N), "+s"(K));
    if (G == 0) { G = (int)gridDim.x; c = (int)bidx(); }
    pg8::Gemm g{A, Bt, M, N, K, 0}; pg8::StaticOrder S; S.init(M, N, G, c);
    pg8::EpiBf E{O, ldc, split_cols, split_stride};
    pg8::gemm_phase<pg8::EpiBf, pg8::StaticOrder>((LAS unsigned char*)lds, g, S, E);
    __syncthreads();
}

DI void run_gemm_act(unsigned char* lds, const bf16_t* U, const bf16_t* Bt, int nrows, bf16_t* H, const float* cw) {
    int K = D, nM = (nrows + 247) / 248, nN = FH / 128;
    asm volatile("" : "+s"(K), "+s"(nM), "+s"(nN));
    pg8::Gemm g{U - D, Bt, nrows, 2 * FH, K, 62}; pg8::StaticOrder S; S.init_tiles(nM, nN, (int)gridDim.x, bidx());
    bf16_t* taps = (bf16_t*)(lds + pg8::STAGE_BYTES);
    for (int i = tidx(); i < 3 * FH; i += NTHR) taps[i] = f2bf(cw[i]);
    __syncthreads();
    pg8::EpiAct E{H, taps, nrows};
    pg8::gemm_phase<pg8::EpiAct, pg8::StaticOrder>((LAS unsigned char*)lds, g, S, E);
    __syncthreads();
}

DI void run_gemm_in1(unsigned char* lds, const bf16_t* U, const bf16_t* Bt, bf16_t* P, bf16_t* X, const float* cw, const float* cb) {
    int K = D, nM = (MT + 239) / 240, nN = NP1 / 256;
    asm volatile("" : "+s"(K), "+s"(nM), "+s"(nN));
    pg8::Gemm g{U - 2 * D, Bt, MT, NP1, K, 60}; pg8::StaticOrder S; S.init_tiles(nM, nN, (int)gridDim.x, bidx());
    bf16_t* taps = (bf16_t*)(lds + pg8::STAGE_BYTES);
    for (int i = tidx(); i < 6 * 1024; i += NTHR) taps[i] = f2bf(i < 5120 ? cw[i] : cb[i - 5120]);
    __syncthreads();
    pg8::EpiConv5 E{P, X, taps, taps + 5120, MT};
    pg8::gemm_phase<pg8::EpiConv5, pg8::StaticOrder>((LAS unsigned char*)lds, g, S, E);
    __syncthreads();
}

struct TileJob { const float* src; bf16_t* dst; int ld, K, ilv, nt, kt; };
DI TileJob tile_job(const Params& p, int ti) {
    const float* src; bf16_t* dst; int ld, ncols, K, ilv = 0;
    if (ti < 576) { src = p.ev_w_in; dst = (bf16_t*)(p.ws + WS_WT_IN0); ld = 2320; ncols = NP0; K = D; }
    else if ((ti -= 576) < 768) { src = p.od_w_in; dst = (bf16_t*)(p.ws + WS_WT_IN1); ld = 3088; ncols = NP1; K = D; }
    else if ((ti -= 768) < 256) { src = p.ev_w_out; dst = (bf16_t*)(p.ws + WS_WT_OUT0); ld = D; ncols = D; K = D; }
    else if ((ti -= 256) < 256) { src = p.od_w_out; dst = (bf16_t*)(p.ws + WS_WT_OUT1); ld = D; ncols = D; K = D; }
    else if ((ti -= 256) < 704) { src = p.ffn_w_gate; dst = (bf16_t*)(p.ws + WS_WT_GU0); ld = FH; ncols = FH; K = D; ilv = 1; }
    else if ((ti -= 704) < 704) { src = p.ffn_w_up; dst = (bf16_t*)(p.ws + WS_WT_GU0); ld = FH; ncols = FH; K = D; ilv = 2; }
    else if ((ti -= 704) < 704) { src = p.ffn_w_gate + (size_t)D * FH; dst = (bf16_t*)(p.ws + WS_WT_GU1); ld = FH; ncols = FH; K = D; ilv = 1; }
    else if ((ti -= 704) < 704) { src = p.ffn_w_up + (size_t)D * FH; dst = (bf16_t*)(p.ws + WS_WT_GU1); ld = FH; ncols = FH; K = D; ilv = 2; }
    else if ((ti -= 704) < 704) { src = p.ffn_w_down; dst = (bf16_t*)(p.ws + WS_WT_DN0); ld = D; ncols = D; K = FH; }
    else { ti -= 704; src = p.ffn_w_down + (size_t)FH * D; dst = (bf16_t*)(p.ws + WS_WT_DN1); ld = D; ncols = D; K = FH; }
    const int ntn = ncols / 64;
    return TileJob{src, dst, ld, K, ilv, ti % ntn, ti / ntn};
}
DI void phase_prep(const Params& p, unsigned char* lds) {
    const int tid = tidx();
    if (bidx() == (int)gridDim.x - 1) { float* tab = (float*)(p.ws + WS_ROPE);
        for (int i = tid; i < 1024; i += NTHR) { const float inv = expf(-(float)(i & 15) * (9.210340371976184f / 16.f)); float sn, cs; sincosf((float)(i >> 4) * inv, &sn, &cs); tab[i] = cs; tab[1024 + i] = sn; } }
    float* sc = (float*)lds;
    float* tile = (float*)(lds + 40960);
    float* mods = (float*)(p.ws + WS_MODS);
    constexpr int NTILE = 6080;
    for (int item = bidx(); item < 192; item += gridDim.x) {
        if (item < 192) {
            const int l = item / 96, nc = item % 96, wv = tid >> 6, ln = tid & 63;
            for (int i = tid; i < 9 * 1024; i += NTHR) { const float v = (i < 8192) ? p.c[i] : p.c_ctx[i - 8192]; sc[i] = v / (1.f + expf(-v)); }
            __syncthreads();
            const int n = nc * 64 + ln;
            float acc[9];
#pragma unroll
            for (int i = 0; i < 9; ++i) acc[i] = 0.f;
            const float* w = p.mod_w + ((size_t)l * 1024 + wv * 128) * 6144 + n;
#pragma unroll 8
            for (int k = 0; k < 128; ++k) { const float wvv = w[(size_t)k * 6144];
#pragma unroll
                for (int i = 0; i < 9; ++i) acc[i] += sc[i * 1024 + wv * 128 + k] * wvv; }
            float* red = tile;
#pragma unroll
            for (int i = 0; i < 9; ++i) red[(wv * 9 + i) * 64 + ln] = acc[i];
            __syncthreads();
            for (int o = tid; o < 9 * 64; o += NTHR) { const int i = o >> 6, c = o & 63; float sum = p.mod_b[l * 6144 + nc * 64 + c];
#pragma unroll
                for (int q = 0; q < 8; ++q) sum += red[(q * 9 + i) * 64 + c];
                mods[(size_t)(l * 9 + i) * 6144 + nc * 64 + c] = sum; }
            __syncthreads();
        }
    }
    {
        const int G = (int)gridDim.x, b0 = bidx();
        const int lr = tid >> 4, lc = (tid & 15) * 4, sn = tid >> 3, sk = (tid & 7) * 8;
        f32x4 cur[2], nxt[2]; TileJob jc, jn;
        int ti = b0;
        if (ti < NTILE) { jc = tile_job(p, ti);
#pragma unroll
            for (int i = 0; i < 2; ++i) cur[i] = *(const f32x4*)(jc.src + (size_t)(jc.kt * 64 + lr + 32 * i) * jc.ld + jc.nt * 64 + lc); }
        for (; ti < NTILE; ti += G) {
            const bool more = ti + G < NTILE;
            if (more) { jn = tile_job(p, ti + G);
#pragma unroll
                for (int i = 0; i < 2; ++i) nxt[i] = *(const f32x4*)(jn.src + (size_t)(jn.kt * 64 + lr + 32 * i) * jn.ld + jn.nt * 64 + lc); }
#pragma unroll
            for (int i = 0; i < 2; ++i) { float* tp = tile + (lr + 32 * i) * 65 + lc; tp[0] = cur[i][0]; tp[1] = cur[i][1]; tp[2] = cur[i][2]; tp[3] = cur[i][3]; }
            __syncthreads();
            { const int n = jc.nt * 64 + sn, nr = jc.ilv ? ((n >> 7) << 8) + (n & 127) + (jc.ilv == 2 ? 128 : 0) : n;
              u32x4 w; w.x = pk2(tile[(sk + 0) * 65 + sn], tile[(sk + 1) * 65 + sn]); w.y = pk2(tile[(sk + 2) * 65 + sn], tile[(sk + 3) * 65 + sn]);
              w.z = pk2(tile[(sk + 4) * 65 + sn], tile[(sk + 5) * 65 + sn]); w.w = pk2(tile[(sk + 6) * 65 + sn], tile[(sk + 7) * 65 + sn]);
              *(u32x4*)(jc.dst + (size_t)nr * jc.K + jc.kt * 64 + sk) = w; }
            __syncthreads();
            if (more) { jc = jn; cur[0] = nxt[0]; cur[1] = nxt[1]; }
        }
    }
}

struct RNArgs {
    const float* hin_lat; const float* hin_ctx; const bf16_t* yo; const float* gy; const float* gatev;
    float* hout_lat; float* hout_ctx;
    const float* gu; const float* shiftv; const float* scalev; bf16_t* u;
    const float* gw; int gw_ld; float* gates; int nrows; int row_begin;
};
#define RN_STEP(N, BIT) { const bool hi_ = (lane & (BIT)) != 0; _Pragma("unroll") for (int j = 0; j < (N); ++j) { \
        const float keep_ = hi_ ? acc[j + (N)] : acc[j], send_ = hi_ ? acc[j] : acc[j + (N)]; acc[j] = keep_ + __shfl_xor(send_, (BIT)); } }
template <int NR, bool SETUP>
DI void phase_rownorm_t(const RNArgs& a, unsigned char* lds, int blk = -1, int nblk = 0) {
    if (blk < 0) { blk = bidx(); nblk = (int)gridDim.x; }
    const int lane = tidx() & 63, wave = tidx() >> 6;
    const int ngroups = a.nrows / NR;
    float* Lgg = (float*)lds; float* Lgs = Lgg + 9216; float* Lsh = Lgs + 9216;
    float* gwT = (float*)lds;
    if (SETUP && a.gw) {
        for (int idx = tidx(); idx < 16384; idx += NTHR) { const int k = idx >> 4, j = idx & 15; gwT[j * 1024 + k] = a.gw[(size_t)k * a.gw_ld + j]; }
        __syncthreads();
    }
    for (int grp = blk * 8 + wave; grp < ngroups; grp += nblk * 8) {
        const int row0 = a.row_begin + grp * NR;
        const int bi = row0 < ML ? (row0 >> 12) : 8;
        const float* hin = row0 < ML ? a.hin_lat + (size_t)row0 * D : a.hin_ctx + (size_t)(row0 - ML) * D;
        f32x4 v[NR][4];
#pragma unroll
        for (int rr = 0; rr < NR; ++rr)
#pragma unroll
            for (int i = 0; i < 4; ++i) v[rr][i] = __builtin_nontemporal_load((const f32x4*)(hin + (size_t)rr * D + i * 256 + lane * 4));
        if (a.yo) {
            u32x2 yw[NR][4]; float rstd[NR];
#pragma unroll
            for (int rr = 0; rr < NR; ++rr)
#pragma unroll
                for (int i = 0; i < 4; ++i) yw[rr][i] = *(const u32x2*)(a.yo + (size_t)(row0 + rr) * D + i * 256 + lane * 4);
#pragma unroll
            for (int rr = 0; rr < NR; ++rr) { float ss = 0.f;
#pragma unroll
                for (int i = 0; i < 4; ++i) { const float y0 = lo16(yw[rr][i].x), y1 = hi16(yw[rr][i].x), y2 = lo16(yw[rr][i].y), y3 = hi16(yw[rr][i].y); ss += y0 * y0 + y1 * y1 + y2 * y2 + y3 * y3; }
                rstd[rr] = ss; }
#pragma unroll
            for (int rr = 0; rr < NR; ++rr) rstd[rr] = rsqrtf(wave_sum(rstd[rr]) * (1.f / D) + EPS);
            __builtin_amdgcn_sched_barrier(0);
            float* hout = row0 < ML ? a.hout_lat + (size_t)row0 * D : a.hout_ctx + (size_t)(row0 - ML) * D;
#pragma unroll
            for (int i = 0; i < 4; ++i) { const int c = i * 256 + lane * 4;
                const f32x4 gg = *(const f32x4*)(a.gy + c) * *(const f32x4*)(a.gatev + (size_t)bi * 6144 + c);
#pragma unroll
                for (int rr = 0; rr < NR; ++rr) { const f32x4 y = (f32x4){lo16(yw[rr][i].x), hi16(yw[rr][i].x), lo16(yw[rr][i].y), hi16(yw[rr][i].y)};
                    v[rr][i] = v[rr][i] + gg * (y * rstd[rr]);
                    __builtin_nontemporal_store(v[rr][i], (f32x4*)(hout + (size_t)rr * D + c)); } }
        }
        if (a.u) {
            float rstd[NR];
#pragma unroll
            for (int rr = 0; rr < NR; ++rr) { float ss = 0.f;
#pragma unroll
                for (int i = 0; i < 4; ++i) ss += v[rr][i][0] * v[rr][i][0] + v[rr][i][1] * v[rr][i][1] + v[rr][i][2] * v[rr][i][2] + v[rr][i][3] * v[rr][i][3];
                rstd[rr] = ss; }
#pragma unroll
            for (int rr = 0; rr < NR; ++rr) rstd[rr] = rsqrtf(wave_sum(rstd[rr]) * (1.f / D) + EPS);
            __builtin_amdgcn_sched_barrier(0);
#pragma unroll
            for (int i = 0; i < 4; ++i) { const int c = i * 256 + lane * 4;
                const f32x4 gs = *(const f32x4*)(a.gu + c) * (*(const f32x4*)(a.scalev + (size_t)bi * 6144 + c) + 1.f), sh = *(const f32x4*)(a.shiftv + (size_t)bi * 6144 + c);
#pragma unroll
                for (int rr = 0; rr < NR; ++rr) { v[rr][i] = (v[rr][i] * rstd[rr]) * gs + sh;
                    u32x2 w; w.x = pk2(v[rr][i][0], v[rr][i][1]); w.y = pk2(v[rr][i][2], v[rr][i][3]);
                    *(u32x2*)(a.u + (size_t)(row0 + rr) * D + c) = w; } }
            if (a.gw) {
                float acc[NR * 16];
                int lo4 = lane * 4; asm volatile("" : "+v"(lo4));
#pragma unroll
                for (int j = 0; j < NR * 16; ++j) acc[j] = 0.f;
#pragma unroll
                for (int j = 0; j < 16; ++j) {
#pragma unroll
                    for (int i = 0; i < 4; ++i) { const f32x4 w4 = *(const f32x4*)(gwT + j * 1024 + i * 256 + lo4);
#pragma unroll
                        for (int rr = 0; rr < NR; ++rr) acc[rr * 16 + j] += v[rr][i][0] * w4[0] + v[rr][i][1] * w4[1] + v[rr][i][2] * w4[2] + v[rr][i][3] * w4[3]; }
                    __builtin_amdgcn_sched_barrier(0); }
                if constexpr (NR == 4) { RN_STEP(32, 32) RN_STEP(16, 16) RN_STEP(8, 8) RN_STEP(4, 4) RN_STEP(2, 2) RN_STEP(1, 1)
                    a.gates[(size_t)row0 * 16 + lane] = acc[0]; }
                else { RN_STEP(8, 32) RN_STEP(4, 16) RN_STEP(2, 8) RN_STEP(1, 4)
                    float t_ = acc[0]; t_ += __shfl_xor(t_, 2); t_ += __shfl_xor(t_, 1);
                    if ((lane & 3) == 0) a.gates[(size_t)row0 * 16 + (lane >> 2)] = t_; }
            }
        }
    }
}

DI void phase_rownorm(const RNArgs& a, unsigned char* lds, int blk = -1, int nblk = 0) {
    if (a.row_begin == 0 && a.nrows == MT && blk < 0) {
        RNArgs l = a; l.nrows = ML; phase_rownorm_t<4, true>(l, lds);
        RNArgs c = a; c.nrows = MC; c.row_begin = ML; phase_rownorm_t<1, false>(c, lds);
    } else if (a.nrows == MC) phase_rownorm_t<1, true>(a, lds, blk, nblk);
    else phase_rownorm_t<4, true>(a, lds, blk, nblk);
}

DI void rope_pass(unsigned char* lds, bf16_t* P, int ld, int h0, int nheads) {
    float* cst = (float*)lds; float* snt = cst + 1024;
    for (int i = tidx(); i < 1024; i += NTHR) { const float inv = expf(-(float)(i & 15) * (9.210340371976184f / 16.f)); float sn, cs; sincosf((float)(i >> 4) * inv, &sn, &cs); cst[i] = cs; snt[i] = sn; }
    __syncthreads();
    const size_t total = (size_t)ML * nheads * 4;
    for (size_t w = (size_t)bidx() * NTHR + tidx(); w < total; w += (size_t)gridDim.x * NTHR) {
        const int sub = (int)(w & 3); const size_t rh = w >> 2; const int head = (int)(rh % nheads); const int row = (int)(rh / nheads);
        const int ax = sub >> 1, i8 = sub & 1, t = row & (T - 1);
        const int pos = ax == 0 ? (t >> 6) : (t & 63);
        bf16_t* ptr = P + (size_t)row * ld + (h0 + head) * 64 + ax * 32 + i8 * 8;
        const u32x4 a = *(const u32x4*)ptr, b = *(const u32x4*)(ptr + 16);
        const float sc = 1.f;
        const f32x4 c0 = *(const f32x4*)(cst + pos * 16 + i8 * 8), c1 = *(const f32x4*)(cst + pos * 16 + i8 * 8 + 4);
        const f32x4 s0 = *(const f32x4*)(snt + pos * 16 + i8 * 8), s1 = *(const f32x4*)(snt + pos * 16 + i8 * 8 + 4);
        const float csv[8] = {c0[0], c0[1], c0[2], c0[3], c1[0], c1[1], c1[2], c1[3]}, snv[8] = {s0[0], s0[1], s0[2], s0[3], s1[0], s1[1], s1[2], s1[3]};
        float x1[8] = {lo16(a.x), hi16(a.x), lo16(a.y), hi16(a.y), lo16(a.z), hi16(a.z), lo16(a.w), hi16(a.w)};
        float x2[8] = {lo16(b.x), hi16(b.x), lo16(b.y), hi16(b.y), lo16(b.z), hi16(b.z), lo16(b.w), hi16(b.w)};
        float o1[8], o2[8];
#pragma unroll
        for (int e = 0; e < 8; ++e) { o1[e] = (x1[e] * csv[e] - x2[e] * snv[e]) * sc; o2[e] = (x2[e] * csv[e] + x1[e] * snv[e]) * sc; }
        u32x4 ra, rb;
        ra.x = pk2(o1[0], o1[1]); ra.y = pk2(o1[2], o1[3]); ra.z = pk2(o1[4], o1[5]); ra.w = pk2(o1[6], o1[7]);
        rb.x = pk2(o2[0], o2[1]); rb.y = pk2(o2[2], o2[3]); rb.z = pk2(o2[4], o2[5]); rb.w = pk2(o2[6], o2[7]);
        *(u32x4*)ptr = ra; *(u32x4*)(ptr + 16) = rb;
    }
    __syncthreads();
}
DI void ctxq_scale(bf16_t* P, int ld) {
    const int total = MC * 64;
    for (int w = bidx() * NTHR + tidx(); w < total; w += gridDim.x * NTHR) {
        const int row = ML + (w >> 6), ch = w & 63; bf16_t* ptr = P + (size_t)row * ld + ch * 8;
        const u32x4 a = *(const u32x4*)ptr; u32x4 r;
        r.x = pk2(lo16(a.x) * QSCALE, hi16(a.x) * QSCALE); r.y = pk2(lo16(a.y) * QSCALE, hi16(a.y) * QSCALE);
        r.z = pk2(lo16(a.z) * QSCALE, hi16(a.z) * QSCALE); r.w = pk2(lo16(a.w) * QSCALE, hi16(a.w) * QSCALE);
        *(u32x4*)ptr = r;
    }
}
DI void conv5_pass(const bf16_t* P, int ld, int col0, int ncols, const float* cw, const float* cb, int nscale, bf16_t* O) {
    const int nch = ncols / 8; const size_t total = (size_t)(MT / 4) * nch;
    for (size_t w = (size_t)bidx() * NTHR + tidx(); w < total; w += (size_t)gridDim.x * NTHR) {
        const int ch = (int)(w % nch), row0 = (int)(w / nch) * 4, c0 = ch * 8;
        int t0, len; if (row0 < ML) { t0 = row0 & (T - 1); len = T; } else { t0 = (row0 - ML) & (CT - 1); len = CT; }
        u32x4 xin[8];
#pragma unroll
        for (int j = 0; j < 8; ++j) { const int tt = t0 + j - 2; xin[j] = (tt < 0 || tt >= len) ? (u32x4){0u, 0u, 0u, 0u} : *(const u32x4*)(P + (size_t)(row0 + j - 2) * ld + col0 + c0); }
        float acc[4][8];
#pragma unroll
        for (int rr = 0; rr < 4; ++rr)
#pragma unroll
            for (int e = 0; e < 8; ++e) acc[rr][e] = cb ? cb[c0 + e] : 0.f;
#pragma unroll
        for (int j = 0; j < 5; ++j) { const f32x4 w0 = *(const f32x4*)(cw + (size_t)j * ncols + c0), w1 = *(const f32x4*)(cw + (size_t)j * ncols + c0 + 4);
#pragma unroll
            for (int rr = 0; rr < 4; ++rr) { const u32x4 a = xin[rr + j];
                acc[rr][0] += lo16(a.x) * w0[0]; acc[rr][1] += hi16(a.x) * w0[1]; acc[rr][2] += lo16(a.y) * w0[2]; acc[rr][3] += hi16(a.y) * w0[3];
                acc[rr][4] += lo16(a.z) * w1[0]; acc[rr][5] += hi16(a.z) * w1[1]; acc[rr][6] += lo16(a.w) * w1[2]; acc[rr][7] += hi16(a.w) * w1[3]; } }
        const float sc = c0 < nscale ? 0.125f : 1.f;
#pragma unroll
        for (int rr = 0; rr < 4; ++rr) { u32x4 r;
            r.x = pk2(silu_f(acc[rr][0]) * sc, silu_f(acc[rr][1]) * sc); r.y = pk2(silu_f(acc[rr][2]) * sc, silu_f(acc[rr][3]) * sc);
            r.z = pk2(silu_f(acc[rr][4]) * sc, silu_f(acc[rr][5]) * sc); r.w = pk2(silu_f(acc[rr][6]) * sc, silu_f(acc[rr][7]) * sc);
            *(u32x4*)(O + (size_t)(row0 + rr) * ncols + c0) = r; }
    }
}
DI void act_pass(const bf16_t* G, bf16_t* U, const float* cw, int nrows) {
    const int nch = FH / 8; const size_t total = (size_t)(nrows / 4) * nch;
    for (size_t w = (size_t)bidx() * NTHR + tidx(); w < total; w += (size_t)gridDim.x * NTHR) {
        const int ch = (int)(w % nch), row0 = (int)(w / nch) * 4, c0 = ch * 8;
        int t0, len; if (row0 < ML) { t0 = row0 & (T - 1); len = T; } else { t0 = (row0 - ML) & (CT - 1); len = CT; }
        u32x4 gin[6], uin[4];
#pragma unroll
        for (int j = 0; j < 6; ++j) { const int tt = t0 + j - 1; gin[j] = (tt < 0 || tt >= len) ? (u32x4){0u, 0u, 0u, 0u} : *(const u32x4*)(G + (size_t)(row0 + j - 1) * FH + c0); }
#pragma unroll
        for (int rr = 0; rr < 4; ++rr) uin[rr] = *(const u32x4*)(U + (size_t)(row0 + rr) * FH + c0);
        float acc[4][8];
#pragma unroll
        for (int rr = 0; rr < 4; ++rr)
#pragma unroll
            for (int e = 0; e < 8; ++e) acc[rr][e] = 0.f;
#pragma unroll
        for (int j = 0; j < 3; ++j) { const f32x4 w0 = *(const f32x4*)(cw + (size_t)j * FH + c0), w1 = *(const f32x4*)(cw + (size_t)j * FH + c0 + 4);
#pragma unroll
            for (int rr = 0; rr < 4; ++rr) { const u32x4 a = gin[rr + j];
                acc[rr][0] += lo16(a.x) * w0[0]; acc[rr][1] += hi16(a.x) * w0[1]; acc[rr][2] += lo16(a.y) * w0[2]; acc[rr][3] += hi16(a.y) * w0[3];
                acc[rr][4] += lo16(a.z) * w1[0]; acc[rr][5] += hi16(a.z) * w1[1]; acc[rr][6] += lo16(a.w) * w1[2]; acc[rr][7] += hi16(a.w) * w1[3]; } }
#pragma unroll
        for (int rr = 0; rr < 4; ++rr) { const u32x4 uu = uin[rr]; u32x4 r;
            r.x = pk2(silu_f(acc[rr][0]) * lo16(uu.x), silu_f(acc[rr][1]) * hi16(uu.x)); r.y = pk2(silu_f(acc[rr][2]) * lo16(uu.y), silu_f(acc[rr][3]) * hi16(uu.y));
            r.z = pk2(silu_f(acc[rr][4]) * lo16(uu.z), silu_f(acc[rr][5]) * hi16(uu.z)); r.w = pk2(silu_f(acc[rr][6]) * lo16(uu.w), silu_f(acc[rr][7]) * hi16(uu.w));
            *(u32x4*)(U + (size_t)(row0 + rr) * FH + c0) = r; }
    }
}

DI int swap23(int k) { return (k & ~12) | ((k & 4) << 1) | ((k & 8) >> 1); }
template <int DV, bool VTG>
DI void attn_run(unsigned char* lds, const bf16_t* P, int ld, int qrow, int qcol, const float* rope_tab, int qpos, int kcol, int vcol, const bf16_t* vtg, int vt_lat0,
                 int lat_row0, int n_lat, int ctx_row0, int n_ctx, bool windowed, int tq, int tk0, int tqw0,
                 float m_init, float l_init, f32x16 (&o)[DV / 32]) {
    constexpr int KSZ = 64 * 72, VSZ = DV * 72;
    bf16_t* Kb = (bf16_t*)lds;
    bf16_t* Vb = Kb + 2 * KSZ;
    const int tid = tidx(), lane = tid & 63, r = lane & 31, h = lane >> 5;
    constexpr int NV = DV / 64, NT = DV / 32;
    bf16x8 qf[4];
    {
        u32x4 qraw[4];
#pragma unroll
        for (int ks = 0; ks < 4; ++ks) qraw[ks] = *(const u32x4*)(P + (size_t)qrow * ld + qcol + ks * 16 + h * 8);
#pragma unroll
        for (int ax = 0; ax < 2; ++ax) {
            float cs[8], sn[8];
            if (rope_tab) { const int pos = ax == 0 ? (qpos >> 6) : (qpos & 63); const float* tb = rope_tab + pos * 16 + h * 8;
                const f32x4 c0 = *(const f32x4*)tb, c1 = *(const f32x4*)(tb + 4), s0 = *(const f32x4*)(tb + 1024), s1 = *(const f32x4*)(tb + 1028);
#pragma unroll
                for (int e = 0; e < 4; ++e) { cs[e] = c0[e]; cs[4 + e] = c1[e]; sn[e] = s0[e]; sn[4 + e] = s1[e]; } }
            else {
#pragma unroll
                for (int e = 0; e < 8; ++e) { cs[e] = 1.f; sn[e] = 0.f; } }
            const u32x4 a = qraw[2 * ax], b = qraw[2 * ax + 1];
            const float x1[8] = {lo16(a.x), hi16(a.x), lo16(a.y), hi16(a.y), lo16(a.z), hi16(a.z), lo16(a.w), hi16(a.w)};
            const float x2[8] = {lo16(b.x), hi16(b.x), lo16(b.y), hi16(b.y), lo16(b.z), hi16(b.z), lo16(b.w), hi16(b.w)};
            float o1[8], o2[8];
#pragma unroll
            for (int e = 0; e < 8; ++e) { o1[e] = (x1[e] * cs[e] - x2[e] * sn[e]) * QSCALE; o2[e] = (x2[e] * cs[e] + x1[e] * sn[e]) * QSCALE; }
            u32x4 ra, rb;
            ra.x = pk2(o1[0], o1[1]); ra.y = pk2(o1[2], o1[3]); ra.z = pk2(o1[4], o1[5]); ra.w = pk2(o1[6], o1[7]);
            rb.x = pk2(o2[0], o2[1]); rb.y = pk2(o2[2], o2[3]); rb.z = pk2(o2[4], o2[5]); rb.w = pk2(o2[6], o2[7]);
            qf[2 * ax] = __builtin_bit_cast(bf16x8, ra); qf[2 * ax + 1] = __builtin_bit_cast(bf16x8, rb);
        }
    }
#pragma unroll
    for (int d = 0; d < NT; ++d) o[d] = zero16();
    float m = m_init, l = l_init;
    const int ntile = n_lat + n_ctx;
    const int kkey = tid >> 3, kch = tid & 7, vkey = tid & 63, vch = tid >> 6, vkp = swap23(vkey);
    u32x4 kreg, vreg[NV];
#define ATT_LOAD(t1) do { const int tr_ = (t1) < n_lat ? lat_row0 + (t1) * 64 : ctx_row0 + ((t1) - n_lat) * 64; \
        kreg = *(const u32x4*)(P + (size_t)(tr_ + kkey) * ld + kcol + kch * 8); \
        if (VTG) { const int ki_ = (t1) < n_lat ? vt_lat0 + (t1) * 64 : 4096 + ((t1) - n_lat) * 64; \
            _Pragma("unroll") for (int i = 0; i < NV; ++i) { const int idx_ = tid + NTHR * i; vreg[i] = *(const u32x4*)(vtg + (size_t)(idx_ >> 3) * 4352 + ki_ + (idx_ & 7) * 8); } } \
        else { _Pragma("unroll") for (int i = 0; i < NV; ++i) vreg[i] = *(const u32x4*)(P + (size_t)(tr_ + vkey) * ld + vcol + (vch + 8 * i) * 8); } } while (0)
#define ATT_STORE(buf) do { *(u32x4*)(Kb + (buf) * KSZ + kkey * 72 + kch * 8) = kreg; \
        if (VTG) { _Pragma("unroll") for (int i = 0; i < NV; ++i) { const int idx_ = tid + NTHR * i; *(u32x4*)(Vb + (buf) * VSZ + (idx_ >> 3) * 72 + (idx_ & 7) * 8) = vreg[i]; } } \
        else { _Pragma("unroll") for (int i = 0; i < NV; ++i) { bf16_t* vp = Vb + (buf) * VSZ + (size_t)((vch + 8 * i) * 8) * 72 + vkp; const u32x4 v = vreg[i]; \
            vp[0 * 72] = (bf16_t)(v.x & 0xffff); vp[1 * 72] = (bf16_t)(v.x >> 16); vp[2 * 72] = (bf16_t)(v.y & 0xffff); vp[3 * 72] = (bf16_t)(v.y >> 16); \
            vp[4 * 72] = (bf16_t)(v.z & 0xffff); vp[5 * 72] = (bf16_t)(v.z >> 16); vp[6 * 72] = (bf16_t)(v.w & 0xffff); vp[7 * 72] = (bf16_t)(v.w >> 16); } } } while (0)
    ATT_LOAD(0);
    ATT_STORE(0);
    __syncthreads();
    for (int tt = 0; tt < ntile; ++tt) {
        const bool more = tt + 1 < ntile;
        if (more) ATT_LOAD(tt + 1);
        const bf16_t* Ks = Kb + (tt & 1) * KSZ; const bf16_t* VT = Vb + (tt & 1) * VSZ;
        const bool msk = windowed && tt < n_lat;
        const int tkt = tk0 + tt * 64;
        if (!(msk && (tkt > tqw0 + 31 + 128 || tkt + 63 < tqw0 - 128))) {
        f32x16 s[2];
#pragma unroll
        for (int kt = 0; kt < 2; ++kt) { s[kt] = zero16();
#pragma unroll
            for (int ks = 0; ks < 4; ++ks) { const bf16x8 a = *(const bf16x8*)(Ks + (kt * 32 + r) * 72 + ks * 16 + h * 8); s[kt] = MFMA32(a, qf[ks], s[kt]); } }
        float tmax = -1e30f;
#pragma unroll
        for (int kt = 0; kt < 2; ++kt)
#pragma unroll
            for (int i = 0; i < 16; ++i) { if (msk) { const int dd = tq - (tkt + kt * 32 + crow(i, h)); if (dd > 128 || dd < -128) s[kt][i] = -1e30f; } tmax = fmaxf(tmax, s[kt][i]); }
        tmax = fmaxf(tmax, xor32(tmax, h));
        const float mnew = (tmax > m + 8.f) ? tmax : m;
        if (__any(mnew != m)) {
            const float alpha = __builtin_amdgcn_exp2f(m - mnew);
            l *= alpha; m = mnew;
#pragma unroll
            for (int d = 0; d < NT; ++d)
#pragma unroll
                for (int i = 0; i < 16; ++i) o[d][i] *= alpha;
        }
        f32x2 ls2 = {0.f, 0.f}; const f32x2 m2 = {m, m};
#pragma unroll
        for (int kt = 0; kt < 2; ++kt)
#pragma unroll
            for (int i = 0; i < 8; ++i) { f32x2 sv = {s[kt][2 * i], s[kt][2 * i + 1]}; sv = sv - m2;
                f32x2 pv; pv.x = __builtin_amdgcn_exp2f(sv.x); pv.y = __builtin_amdgcn_exp2f(sv.y);
                s[kt][2 * i] = pv.x; s[kt][2 * i + 1] = pv.y; ls2 = ls2 + pv; }
        l += ls2.x + ls2.y;
#pragma unroll
        for (int kt = 0; kt < 2; ++kt)
#pragma unroll
            for (int st = 0; st < 2; ++st) { const bf16x8 pb = pack8(s[kt], st);
#pragma unroll
                for (int d = 0; d < NT; ++d) { const bf16x8 a = *(const bf16x8*)(VT + (size_t)(d * 32 + r) * 72 + kt * 32 + st * 16 + 8 * h); o[d] = MFMA32(a, pb, o[d]); } }
        }
        if (more) ATT_STORE((tt + 1) & 1);
        __syncthreads();
    }
#undef ATT_LOAD
#undef ATT_STORE
    const float lt = l + xor32(l, h), inv = 1.f / lt;
#pragma unroll
    for (int d = 0; d < NT; ++d)
#pragma unroll
        for (int i = 0; i < 16; ++i) o[d][i] *= inv;
}
DI void vt_pass(const Params& p, unsigned char* lds) {
    const bf16_t* P = (const bf16_t*)(p.ws + WS_BIG + BIG_P); bf16_t* VTg = (bf16_t*)(p.ws + WS_BIG + BIG_VT);
    bf16_t* tile = (bf16_t*)lds;
    const int tid = tidx(), vkey = tid & 63, vch = tid >> 6, vkp = swap23(vkey);
    for (int item = bidx(); item < 8 * 4 * 68; item += gridDim.x) {
        const int kt = item % 68, bh = item / 68, hh = bh & 3, b = bh >> 2;
        const int row = kt < 64 ? b * T + kt * 64 + vkey : ML + b * CT + (kt - 64) * 64 + vkey;
#pragma unroll
        for (int i = 0; i < 2; ++i) { const u32x4 v = *(const u32x4*)(P + (size_t)row * NP1 + 1024 + hh * 128 + (vch + 8 * i) * 8);
            bf16_t* vp = tile + (size_t)((vch + 8 * i) * 8) * 72 + vkp;
            vp[0 * 72] = (bf16_t)(v.x & 0xffff); vp[1 * 72] = (bf16_t)(v.x >> 16); vp[2 * 72] = (bf16_t)(v.y & 0xffff); vp[3 * 72] = (bf16_t)(v.y >> 16);
            vp[4 * 72] = (bf16_t)(v.z & 0xffff); vp[5 * 72] = (bf16_t)(v.z >> 16); vp[6 * 72] = (bf16_t)(v.w & 0xffff); vp[7 * 72] = (bf16_t)(v.w >> 16); }
        __syncthreads();
#pragma unroll
        for (int i = 0; i < 2; ++i) { const int idx = tid + NTHR * i, dv = idx >> 3, c = idx & 7;
            *(u32x4*)(VTg + ((size_t)bh * 128 + dv) * 4352 + kt * 64 + c * 8) = *(const u32x4*)(tile + (size_t)dv * 72 + c * 8); }
        __syncthreads();
    }
}

DI void gqa_item(const Params& p, unsigned char* lds, int item) {
    const bf16_t* P = (const bf16_t*)(p.ws + WS_BIG + BIG_P); bf16_t* Y = (bf16_t*)(p.ws + WS_UY);
    const int lane = tidx() & 63, w = tidx() >> 6, r = lane & 31, h = lane >> 5;
    f32x16 o[2]; int qrow, hq;
    if (item < 1024) {
        const int b = item >> 7; hq = (item >> 4) & 7; const int qb = item & 15;
        const int t0 = qb * 256, tlo = t0 - 128 < 0 ? 0 : t0 - 128, thi = t0 + 384 > T ? T : t0 + 384;
        qrow = b * T + t0 + w * 32 + r;
        attn_run<64, false>(lds, P, NP0, qrow, hq * 64, (const float*)(p.ws + WS_ROPE), t0 + w * 32 + r, 512 + (hq >> 2) * 64, 640 + (hq >> 2) * 64, nullptr, 0, b * T + tlo, (thi - tlo) / 64, ML + b * CT, 4,
                     true, t0 + w * 32 + r, tlo, t0 + w * 32, p.a_sink[hq] * LOG2E, h == 0 ? 1.f : 0.f, o);
    } else {
        const int it = item - 1024, b = it >> 3; hq = it & 7;
        qrow = ML + b * CT + w * 32 + r;
        attn_run<64, false>(lds, P, NP0, qrow, hq * 64, nullptr, 0, 512 + (hq >> 2) * 64, 640 + (hq >> 2) * 64, nullptr, 0, 0, 0, ML + b * CT, 4,
                     false, 0, 0, 0, p.a_sink[hq] * LOG2E, h == 0 ? 1.f : 0.f, o);
    }
#pragma unroll
    for (int d = 0; d < 2; ++d)
#pragma unroll
        for (int g = 0; g < 4; ++g) { u32x2 wv; wv.x = pk2(o[d][4 * g], o[d][4 * g + 1]); wv.y = pk2(o[d][4 * g + 2], o[d][4 * g + 3]);
            *(u32x2*)(Y + (size_t)qrow * D + hq * 64 + d * 32 + 8 * g + 4 * h) = wv; }
}
DI void diff_item(const Params& p, unsigned char* lds, int item, float lam, float lam_init) {
    const bf16_t* P = (const bf16_t*)(p.ws + WS_BIG + BIG_P); bf16_t* Y = (bf16_t*)(p.ws + WS_UY);
    const int lane = tidx() & 63, w = tidx() >> 6, r = lane & 31, h = lane >> 5;
    const int b = item >> 6, hh = (item >> 4) & 3, qb = item & 15;
    const int qrow = b * T + qb * 256 + w * 32 + r;
    f32x16 o0[4];
#pragma unroll 1
    for (int mm = 0; mm < 2; ++mm) {
        attn_run<128, true>(lds, P, NP1, qrow, hh * 128 + mm * 64, (const float*)(p.ws + WS_ROPE), qb * 256 + w * 32 + r, 512 + hh * 128 + mm * 64, 1024 + hh * 128, (const bf16_t*)(p.ws + WS_BIG + BIG_VT) + (size_t)(b * 4 + hh) * 128 * 4352, 0, b * T, 64, ML + b * CT, 4, false, 0, 0, 0, -1e30f, 0.f, o0);
        if (mm == 0) {
#pragma unroll
            for (int d = 0; d < 4; ++d)
#pragma unroll
                for (int g = 0; g < 4; ++g) { u32x2 wv; wv.x = pk2(o0[d][4 * g], o0[d][4 * g + 1]); wv.y = pk2(o0[d][4 * g + 2], o0[d][4 * g + 3]);
                    *(u32x2*)(Y + (size_t)qrow * D + hh * 128 + d * 32 + 8 * g + 4 * h) = wv; }
        }
    }
    float ss = 0.f;
#pragma unroll
    for (int d = 0; d < 4; ++d)
#pragma unroll
        for (int g = 0; g < 4; ++g) { const u32x2 pv = *(const u32x2*)(Y + (size_t)qrow * D + hh * 128 + d * 32 + 8 * g + 4 * h);
            const float v0 = lo16(pv.x) - lam * o0[d][4 * g], v1 = hi16(pv.x) - lam * o0[d][4 * g + 1], v2 = lo16(pv.y) - lam * o0[d][4 * g + 2], v3 = hi16(pv.y) - lam * o0[d][4 * g + 3];
            o0[d][4 * g] = v0; o0[d][4 * g + 1] = v1; o0[d][4 * g + 2] = v2; o0[d][4 * g + 3] = v3; ss += v0 * v0 + v1 * v1 + v2 * v2 + v3 * v3; }
    ss += __shfl_xor(ss, 32);
    const float rstd = rsqrtf(ss * (1.f / 128.f) + EPS) * (1.f - lam_init);
#pragma unroll
    for (int d = 0; d < 4; ++d)
#pragma unroll
        for (int g = 0; g < 4; ++g) { const int dv = d * 32 + 8 * g + 4 * h; const f32x4 gn = *(const f32x4*)(p.c_norm_g + hh * 128 + dv);
            u32x2 wv; wv.x = pk2(o0[d][4 * g] * rstd * gn[0], o0[d][4 * g + 1] * rstd * gn[1]); wv.y = pk2(o0[d][4 * g + 2] * rstd * gn[2], o0[d][4 * g + 3] * rstd * gn[3]);
            *(u32x2*)(Y + (size_t)qrow * D + hh * 128 + dv) = wv; }
}

template <int L> DI int chunk_row0(int b, int dir, int j) {
    constexpr int nctx = CT / L, nlat = T / L;
    if (j < nctx) { const int c = dir ? nctx - 1 - j : j; return ML + b * CT + c * L; }
    int c = j - nctx; c = dir ? nlat - 1 - c : c; return b * T + c * L;
}
template <int L> DI int chunk_j(bool is_ctx, int c, int dir) {
    constexpr int nctx = CT / L, nlat = T / L;
    return is_ctx ? (dir ? nctx - 1 - c : c) : nctx + (dir ? nlat - 1 - c : c);
}
DI float logsigmoid_f(float x) { return fminf(x, 0.f) - log1pf(expf(-fabsf(x))); }
DI float softplus_f(float x) { return fmaxf(x, 0.f) + log1pf(expf(-fabsf(x))); }

DI void mlstm_local_item(const Params& p, unsigned char* lds, int item) {
    const bf16_t* P = (const bf16_t*)(p.ws + WS_BIG + BIG_P); const bf16_t* QKB = (const bf16_t*)(p.ws + WS_BIG + BIG_CV);
    bf16_t* ST = (bf16_t*)(p.ws + WS_BIG + BIG_ST); float* SC = (float*)(p.ws + WS_SC); float* NS = (float*)(p.ws + WS_NS);
    const float* gates = (const float*)(p.ws + WS_GATES);
    bf16_t* VT = (bf16_t*)lds;
    bf16_t* KT = VT + 128 * 72;
    float* lf = (float*)(KT + 2 * 64 * 72); float* li = lf + 128; float* wg = li + 128;
    const int tid = tidx(), lane = tid & 63, w = tid >> 6, r = lane & 31, h2 = lane >> 5;
    const int cc = item % 68, bh = item / 68, hd = bh & 3, b = bh >> 2;
    const bool is_ctx = cc < 4; const int c = is_ctx ? cc : cc - 4;
    const int r0 = is_ctx ? ML + b * CT + c * 64 : b * T + c * 64;
    size_t sit[2];
#pragma unroll
    for (int d = 0; d < 2; ++d) sit[d] = (size_t)((b * 4 + hd) * 2 + d) * 68 + chunk_j<64>(is_ctx, c, d);
    if (tid < 128) { const int d = w, l = lane; const size_t row = r0 + l;
        li[tid] = gates[row * 16 + d * 4 + hd] + p.b_gate_b[d * 4 + hd];
        lf[tid] = logsigmoid_f(gates[row * 16 + 8 + d * 4 + hd] + p.b_gate_b[8 + d * 4 + hd]); }
    __syncthreads();
    if (tid < 128) { const int d = w, l = d ? 63 - lane : lane;
        const float bcv = wave_scan_add(lf[d * 64 + l], lane), btot = __shfl(bcv, 63);
        const float wv = btot - bcv + li[d * 64 + l], mx = wave_max(wv);
        wg[d * 64 + l] = expf(wv - mx);
        if (lane == 0) { SC[sit[d] * 8 + 0] = btot; SC[sit[d] * 8 + 1] = mx; } }
    __syncthreads();
    { const int l = tid & 63, ch = tid >> 6;
      const u32x4 kv = *(const u32x4*)(QKB + (size_t)(r0 + l) * 512 + 256 + hd * 64 + ch * 8);
      const float kf[8] = {lo16(kv.x), hi16(kv.x), lo16(kv.y), hi16(kv.y), lo16(kv.z), hi16(kv.z), lo16(kv.w), hi16(kv.w)};
#pragma unroll
      for (int d = 0; d < 2; ++d) { const float wl = wg[d * 64 + l]; bf16_t* kp = KT + (size_t)(d * 64 + ch * 8) * 72 + l;
#pragma unroll
          for (int e = 0; e < 8; ++e) kp[e * 72] = f2bf(kf[e] * wl); }
#pragma unroll
      for (int it = 0; it < 2; ++it) { const int c8 = ch + 8 * it;
          const u32x4 vv = *(const u32x4*)(P + (size_t)(r0 + l) * NP0 + 1280 + hd * 128 + c8 * 8);
          bf16_t* vp = VT + (size_t)(c8 * 8) * 72 + l;
          vp[0] = (bf16_t)(vv.x & 0xffff); vp[72] = (bf16_t)(vv.x >> 16); vp[144] = (bf16_t)(vv.y & 0xffff); vp[216] = (bf16_t)(vv.y >> 16);
          vp[288] = (bf16_t)(vv.z & 0xffff); vp[360] = (bf16_t)(vv.z >> 16); vp[432] = (bf16_t)(vv.w & 0xffff); vp[504] = (bf16_t)(vv.w >> 16); } }
    __syncthreads();
    { const int rt = w >> 1, ct = w & 1; f32x16 acc[2] = {zero16(), zero16()};
#pragma unroll
      for (int ks = 0; ks < 4; ++ks) { const bf16x8 a = *(const bf16x8*)(VT + (size_t)(rt * 32 + r) * 72 + ks * 16 + h2 * 8);
#pragma unroll
          for (int d = 0; d < 2; ++d) { const bf16x8 bb = *(const bf16x8*)(KT + (size_t)(d * 64 + ct * 32 + r) * 72 + ks * 16 + h2 * 8); acc[d] = MFMA32(a, bb, acc[d]); } }
#pragma unroll
      for (int d = 0; d < 2; ++d) { bf16_t* dst = ST + sit[d] * 8192;
#pragma unroll
          for (int i = 0; i < 16; ++i) dst[(size_t)(rt * 32 + crow(i, h2)) * 64 + ct * 32 + r] = f2bf(acc[d][i]); } }
    if (tid < 128) { const int d = w; float acc = 0.f;
        for (int l = 0; l < 64; l += 2) { const unsigned kk = *(const unsigned*)(KT + (size_t)(d * 64 + lane) * 72 + l); acc += lo16(kk) + hi16(kk); }
        NS[sit[d] * 64 + lane] = acc; }
    __syncthreads();
}
DI void mlstm_scan(const Params& p, unsigned char* lds) {
    bf16_t* ST = (bf16_t*)(p.ws + WS_BIG + BIG_ST); float* SC = (float*)(p.ws + WS_SC); float* NS = (float*)(p.ws + WS_NS);
    float* av = (float*)lds; float* gv = av + 68;
    const int tid = tidx();
    for (int blk = bidx(); blk < 256; blk += gridDim.x) {
        const int seq = blk >> 2, e4 = (blk & 3) * 512 + tid;
        float* blv = gv + 68; float* mlv = blv + 68; float* m0v = mlv + 68;
        if (tid < 68) { const size_t item = (size_t)seq * 68 + tid; blv[tid] = SC[item * 8 + 0]; mlv[tid] = SC[item * 8 + 1]; }
        __syncthreads();
        if (tid == 0) { float m = 0.f;
            for (int j = 0; j < 68; ++j) { const float bl = blv[j], ml = mlv[j];
                const float mnew = fmaxf(bl + m, ml); av[j] = __expf(bl + m - mnew); gv[j] = __expf(ml - mnew);
                m0v[j] = m; m = mnew; } }
        __syncthreads();
        if ((blk & 3) == 0 && tid < 68) SC[((size_t)seq * 68 + tid) * 8 + 2] = m0v[tid];
        float st[4] = {0.f, 0.f, 0.f, 0.f}, ns = 0.f;
        bf16_t* base = ST + ((size_t)seq * 68) * 8192 + e4 * 4;
        u32x2 ring[4];
#pragma unroll
        for (int q = 0; q < 4; ++q) ring[q] = *(const u32x2*)(base + (size_t)q * 8192);
        const bool do_n = (blk & 3) == 0 && tid < 64;
#pragma unroll 4
        for (int j = 0; j < 68; ++j) {
            const u32x2 cur = ring[j & 3];
            if (j + 4 < 68) ring[j & 3] = *(const u32x2*)(base + (size_t)(j + 4) * 8192);
            const float a = av[j], g = gv[j];
            u32x2 o; o.x = pk2(st[0], st[1]); o.y = pk2(st[2], st[3]);
            *(u32x2*)(base + (size_t)j * 8192) = o;
            st[0] = a * st[0] + g * lo16(cur.x); st[1] = a * st[1] + g * hi16(cur.x); st[2] = a * st[2] + g * lo16(cur.y); st[3] = a * st[3] + g * hi16(cur.y);
            if (do_n) { float* np = NS + ((size_t)seq * 68 + j) * 64 + tid; const float nl = *np; *np = ns; ns = a * ns + g * nl; }
        }
        __syncthreads();
    }
}
DI void mlstm_out_item(const Params& p, unsigned char* lds, int item) {
    const bf16_t* P = (const bf16_t*)(p.ws + WS_BIG + BIG_P); const bf16_t* QKB = (const bf16_t*)(p.ws + WS_BIG + BIG_CV);
    const bf16_t* ST = (const bf16_t*)(p.ws + WS_BIG + BIG_ST); const float* SC = (const float*)(p.ws + WS_SC); const float* NS = (const float*)(p.ws + WS_NS);
    const float* gates = (const float*)(p.ws + WS_GATES); bf16_t* Y = (bf16_t*)(p.ws + WS_UY);
    bf16_t* Ks = (bf16_t*)lds;
    bf16_t* VT = Ks + 64 * 72;
    bf16_t* C0 = VT + 128 * 72;
    float* n0 = (float*)(C0 + 2 * 128 * 72);
    float* m0s = n0 + 128;
    float* lf = m0s + 8;
    float* li = lf + 128; float* bc = li + 128; float* c1 = bc + 128; float* pm = c1 + 128; float* red = pm + 128;
    const int tid = tidx(), lane = tid & 63, w = tid >> 6, r = lane & 31, h2 = lane >> 5;
    const int cc = item % 68, bh = item / 68, hd = bh & 3, b = bh >> 2;
    const bool is_ctx = cc < 4; const int c = is_ctx ? cc : cc - 4;
    const int r0 = is_ctx ? ML + b * CT + c * 64 : b * T + c * 64;
    const int tt = w & 1, vp = w >> 1, t = tt * 32 + r;
    if (tid < 128) { const int d = tid >> 6, l = tid & 63; const size_t row = r0 + l;
        li[tid] = gates[row * 16 + d * 4 + hd] + p.b_gate_b[d * 4 + hd];
        lf[tid] = logsigmoid_f(gates[row * 16 + 8 + d * 4 + hd] + p.b_gate_b[8 + d * 4 + hd]); }
    __syncthreads();
    if (tid < 128) { const int d = w, l = d ? 63 - lane : lane;
        const float bcv = wave_scan_add(lf[d * 64 + l], lane), cv = li[d * 64 + l] - bcv;
        bc[d * 64 + l] = bcv; c1[d * 64 + l] = cv; pm[d * 64 + l] = wave_scan_max(cv, lane); }
    { const int s = tid >> 3, ch = tid & 7;
      *(u32x4*)(Ks + (size_t)s * 72 + ch * 8) = *(const u32x4*)(QKB + (size_t)(r0 + s) * 512 + 256 + hd * 64 + ch * 8);
      const int l = tid & 63, c8 = tid >> 6;
#pragma unroll
      for (int it = 0; it < 2; ++it) { const int cq = c8 + 8 * it;
          const u32x4 vv = *(const u32x4*)(P + (size_t)(r0 + l) * NP0 + 1280 + hd * 128 + cq * 8);
          bf16_t* vq = VT + (size_t)(cq * 8) * 72 + l;
          vq[0] = (bf16_t)(vv.x & 0xffff); vq[72] = (bf16_t)(vv.x >> 16); vq[144] = (bf16_t)(vv.y & 0xffff); vq[216] = (bf16_t)(vv.y >> 16);
          vq[288] = (bf16_t)(vv.z & 0xffff); vq[360] = (bf16_t)(vv.z >> 16); vq[432] = (bf16_t)(vv.w & 0xffff); vq[504] = (bf16_t)(vv.w >> 16); } }
    bf16x8 qf[4];
#pragma unroll
    for (int ks = 0; ks < 4; ++ks) qf[ks] = *(const bf16x8*)(QKB + (size_t)(r0 + t) * 512 + hd * 64 + ks * 16 + h2 * 8);
#pragma unroll
    for (int d = 0; d < 2; ++d) {
        const size_t sit = (size_t)((b * 4 + hd) * 2 + d) * 68 + chunk_j<64>(is_ctx, c, d);
#pragma unroll
        for (int it = 0; it < 2; ++it) { const int idx = tid + NTHR * it, dv = idx >> 3, ch = idx & 7;
            *(u32x4*)(C0 + (size_t)(d * 128 + dv) * 72 + ch * 8) = *(const u32x4*)(ST + sit * 8192 + dv * 64 + ch * 8); }
        if (tid < 64) n0[d * 64 + tid] = NS[sit * 64 + tid];
        if (tid == 64) m0s[d] = SC[sit * 8 + 2]; }
    __syncthreads();
    f32x16 x[2];
#pragma unroll
    for (int st = 0; st < 2; ++st) { x[st] = zero16();
#pragma unroll
        for (int ks = 0; ks < 4; ++ks) { const bf16x8 a = *(const bf16x8*)(Ks + (size_t)(st * 32 + r) * 72 + ks * 16 + h2 * 8); x[st] = MFMA32(a, qf[ks], x[st]); } }
    f32x16 hsum = zero16();
#pragma unroll 1
    for (int d = 0; d < 2; ++d) {
        const float m0 = m0s[d];
        const float mx = fmaxf(pm[d * 64 + t], m0), ain = __expf(m0 - mx);
        f32x16 wv[2]; float sumw = 0.f;
#pragma unroll
        for (int st = 0; st < 2; ++st)
#pragma unroll
            for (int i = 0; i < 16; ++i) { const int s = st * 32 + crow(i, h2); const bool valid = d ? (s >= t) : (s <= t);
                const float v = valid ? x[st][i] * __expf(c1[d * 64 + s] - mx) : 0.f; wv[st][i] = v; sumw += v; }
        sumw += __shfl_xor(sumw, 32);
        f32x16 acc = zero16(), acc2 = zero16();
#pragma unroll
        for (int st = 0; st < 2; ++st)
#pragma unroll
            for (int sb = 0; sb < 2; ++sb) { const bf16x8 pb = pack8(wv[st], sb);
                const bf16x8 a = ld_tr2(VT + (size_t)(vp * 32 + r) * 72 + st * 32 + sb * 16 + 4 * h2); acc = MFMA32(a, pb, acc); }
        float nq = 0.f;
#pragma unroll
        for (int ks = 0; ks < 4; ++ks) { const bf16x8 a = *(const bf16x8*)(C0 + (size_t)(d * 128 + vp * 32 + r) * 72 + ks * 16 + h2 * 8); acc2 = MFMA32(a, qf[ks], acc2);
#pragma unroll
            for (int e = 0; e < 8; ++e) nq += n0[d * 64 + ks * 16 + h2 * 8 + e] * bf2f((bf16_t)qf[ks][e]); }
        nq += __shfl_xor(nq, 32);
        float den = sumw + ain * nq; const float mt = bc[d * 64 + t] + mx;
        den = fmaxf(fabsf(den), __expf(-mt));
        const float rden = 1.f / den;
#pragma unroll
        for (int i = 0; i < 16; ++i) hsum[i] += (acc[i] + ain * acc2[i]) * rden;
    }
    float ss = 0.f;
#pragma unroll
    for (int i = 0; i < 16; ++i) ss += hsum[i] * hsum[i];
    ss += __shfl_xor(ss, 32);
    if (h2 == 0) red[vp * 64 + t] = ss;
    __syncthreads();
    const float rstd = rsqrtf((red[t] + red[64 + t] + red[128 + t] + red[192 + t]) * (1.f / 128.f) + EPS);
#pragma unroll
    for (int g = 0; g < 4; ++g) { const int dv = vp * 32 + 8 * g + 4 * h2;
        const u32x2 og = *(const u32x2*)(P + (size_t)(r0 + t) * NP0 + 1792 + hd * 128 + dv); const f32x4 gn = *(const f32x4*)(p.b_norm_g + hd * 128 + dv);
        u32x2 wv2; wv2.x = pk2(hsum[4 * g] * rstd * gn[0] * sigmoid_f(lo16(og.x)), hsum[4 * g + 1] * rstd * gn[1] * sigmoid_f(hi16(og.x)));
        wv2.y = pk2(hsum[4 * g + 2] * rstd * gn[2] * sigmoid_f(lo16(og.y)), hsum[4 * g + 3] * rstd * gn[3] * sigmoid_f(hi16(og.y)));
        *(u32x2*)(Y + (size_t)(r0 + t) * D + 512 + hd * 128 + dv) = wv2; }
    __syncthreads();
}

DI void ssd_local_item(const Params& p, unsigned char* lds, int item) {
    const bf16_t* XBC = (const bf16_t*)(p.ws + WS_BIG + BIG_CV);
    bf16_t* ST = (bf16_t*)(p.ws + WS_BIG + BIG_ST); float* SC = (float*)(p.ws + WS_SC); const float* gates = (const float*)(p.ws + WS_GATES);
    bf16_t* KT = (bf16_t*)lds;
    bf16_t* VT = KT + 128 * 136;
    float* av = (float*)(VT + 256 * 136); float* dtv = av + 512; float* ac = dtv + 512; float* wg = ac + 512; float* scal = wg + 512;
    const int tid = tidx(), lane = tid & 63, w = tid >> 6, r = lane & 31, h2 = lane >> 5;
    const int j = item % 34, seq = item / 34, dir = seq & 1, grp = (seq >> 1) & 1, b = seq >> 2;
    const int r0 = chunk_row0<128>(b, dir, j);
    { const int hh = tid >> 7, l = tid & 127, head = grp * 4 + hh;
      const float dt = softplus_f(gates[(size_t)(r0 + l) * 16 + dir * 8 + head] + p.d_dt_bias[dir * 8 + head]);
      dtv[tid] = dt; av[tid] = -dt * expf(p.d_a_log[dir * 8 + head]); }
    __syncthreads();
    if (tid < 256) { const int hh = w, l0 = dir ? 127 - 2 * lane : 2 * lane, l1 = dir ? 126 - 2 * lane : 2 * lane + 1;
        const float a0 = av[hh * 128 + l0], a1 = av[hh * 128 + l1], pv = wave_scan_add(a0 + a1, lane), tot = __shfl(pv, 63);
        ac[hh * 128 + l1] = pv; ac[hh * 128 + l0] = pv - a1;
        if (lane == 0) { scal[hh] = tot; SC[(size_t)item * 8 + hh] = tot; } }
    __syncthreads();
    { const int hh = tid >> 7; wg[tid] = expf(scal[hh] - ac[tid]) * dtv[tid]; }
    __syncthreads();
    { const int l = tid & 127, c4 = tid >> 7;
#pragma unroll
      for (int it = 0; it < 4; ++it) { const int ch = c4 + 4 * it;
          const u32x4 kv = *(const u32x4*)(XBC + (size_t)(r0 + l) * 1024 + 512 + grp * 128 + ch * 8);
          bf16_t* kp = KT + (size_t)(ch * 8) * 136 + l;
          kp[0] = (bf16_t)(kv.x & 0xffff); kp[136] = (bf16_t)(kv.x >> 16); kp[272] = (bf16_t)(kv.y & 0xffff); kp[408] = (bf16_t)(kv.y >> 16);
          kp[544] = (bf16_t)(kv.z & 0xffff); kp[680] = (bf16_t)(kv.z >> 16); kp[816] = (bf16_t)(kv.w & 0xffff); kp[952] = (bf16_t)(kv.w >> 16); }
#pragma unroll
      for (int it = 0; it < 8; ++it) { const int ch = c4 + 4 * it, hh = ch >> 3; const float wl = wg[hh * 128 + l];
          const u32x4 vv = *(const u32x4*)(XBC + (size_t)(r0 + l) * 1024 + grp * 256 + ch * 8);
          bf16_t* vp = VT + (size_t)(ch * 8) * 136 + l;
          vp[0] = f2bf(lo16(vv.x) * wl); vp[136] = f2bf(hi16(vv.x) * wl); vp[272] = f2bf(lo16(vv.y) * wl); vp[408] = f2bf(hi16(vv.y) * wl);
          vp[544] = f2bf(lo16(vv.z) * wl); vp[680] = f2bf(hi16(vv.z) * wl); vp[816] = f2bf(lo16(vv.w) * wl); vp[952] = f2bf(hi16(vv.w) * wl); } }
    __syncthreads();
    { f32x16 acc[4];
#pragma unroll
      for (int ct = 0; ct < 4; ++ct) acc[ct] = zero16();
#pragma unroll
      for (int ks = 0; ks < 8; ++ks) { const bf16x8 a = *(const bf16x8*)(VT + (size_t)(w * 32 + r) * 136 + ks * 16 + h2 * 8);
#pragma unroll
          for (int ct = 0; ct < 4; ++ct) { const bf16x8 bb = *(const bf16x8*)(KT + (size_t)(ct * 32 + r) * 136 + ks * 16 + h2 * 8); acc[ct] = MFMA32(a, bb, acc[ct]); } }
      bf16_t* dst = ST + (size_t)item * 32768;
#pragma unroll
      for (int ct = 0; ct < 4; ++ct)
#pragma unroll
          for (int i = 0; i < 16; ++i) dst[(size_t)(w * 32 + crow(i, h2)) * 128 + ct * 32 + r] = f2bf(acc[ct][i]); }
    __syncthreads();
}
DI void ssd_scan(const Params& p, unsigned char* lds) {
    bf16_t* ST = (bf16_t*)(p.ws + WS_BIG + BIG_ST); const float* SC = (const float*)(p.ws + WS_SC);
    float* dec = (float*)lds;
    const int tid = tidx();
    for (int blk = bidx(); blk < 256; blk += gridDim.x) {
        const int seq = blk >> 3, e8 = (blk & 7) * 512 + tid, hh = e8 >> 10;
        if (tid < 136) dec[tid] = expf(SC[((size_t)seq * 34 + (tid >> 2)) * 8 + (tid & 3)]);
        __syncthreads();
        float st[8];
#pragma unroll
        for (int e = 0; e < 8; ++e) st[e] = 0.f;
        bf16_t* base = ST + ((size_t)seq * 34) * 32768 + e8 * 8;
        u32x4 ring[4];
#pragma unroll
        for (int q = 0; q < 4; ++q) ring[q] = *(const u32x4*)(base + (size_t)q * 32768);
#pragma unroll 4
        for (int j = 0; j < 34; ++j) {
            const u32x4 cur = ring[j & 3];
            if (j + 4 < 34) ring[j & 3] = *(const u32x4*)(base + (size_t)(j + 4) * 32768);
            const float a = dec[j * 4 + hh];
            u32x4 o; o.x = pk2(st[0], st[1]); o.y = pk2(st[2], st[3]); o.z = pk2(st[4], st[5]); o.w = pk2(st[6], st[7]);
            *(u32x4*)(base + (size_t)j * 32768) = o;
            st[0] = a * st[0] + lo16(cur.x); st[1] = a * st[1] + hi16(cur.x); st[2] = a * st[2] + lo16(cur.y); st[3] = a * st[3] + hi16(cur.y);
            st[4] = a * st[4] + lo16(cur.z); st[5] = a * st[5] + hi16(cur.z); st[6] = a * st[6] + lo16(cur.w); st[7] = a * st[7] + hi16(cur.w);
        }
        __syncthreads();
    }
}
DI void ssd_out_item(const Params& p, unsigned char* lds, int item) {
    const bf16_t* P = (const bf16_t*)(p.ws + WS_BIG + BIG_P); const bf16_t* XBC = (const bf16_t*)(p.ws + WS_BIG + BIG_CV);
    const bf16_t* ST = (const bf16_t*)(p.ws + WS_BIG + BIG_ST); const float* gates = (const float*)(p.ws + WS_GATES); bf16_t* Y = (bf16_t*)(p.ws + WS_UY);
    bf16_t* Bs = (bf16_t*)lds;
    bf16_t* XT = Bs + 128 * 136;
    bf16_t* H0 = XT + 256 * 136;
    float* ac = (float*)(H0 + 64 * 136);
    float* dtv = ac + 1024; float* red = dtv + 1024;
    const int tid = tidx(), lane = tid & 63, w = tid >> 6, r = lane & 31, h2 = lane >> 5;
    const int c = item & 31, bg = item >> 5, grp = bg & 1, b = bg >> 1;
    const int r0 = b * T + c * 128;
    const int tt = w & 3, pp = w >> 2, t = tt * 32 + r;
#pragma unroll
    for (int it = 0; it < 2; ++it) { const int idx = tid + NTHR * it, d = idx >> 9, hh = (idx >> 7) & 3, l = idx & 127, head = grp * 4 + hh;
        const float dt = softplus_f(gates[(size_t)(r0 + l) * 16 + d * 8 + head] + p.d_dt_bias[d * 8 + head]);
        dtv[idx] = dt; ac[idx] = -dt * expf(p.d_a_log[d * 8 + head]); }
    __syncthreads();
    { const int d = w >> 2, l0 = d ? 127 - 2 * lane : 2 * lane, l1 = d ? 126 - 2 * lane : 2 * lane + 1;
      const float a0 = ac[w * 128 + l0], a1 = ac[w * 128 + l1], pv = wave_scan_add(a0 + a1, lane);
      ac[w * 128 + l1] = pv; ac[w * 128 + l0] = pv - a1;
      dtv[w * 128 + l1] = pv * LOG2E - __log2f(dtv[w * 128 + l1]); dtv[w * 128 + l0] = (pv - a1) * LOG2E - __log2f(dtv[w * 128 + l0]); }
    { const int l = tid & 127, c4 = tid >> 7;
#pragma unroll
      for (int it = 0; it < 4; ++it) { const int ch = c4 + 4 * it;
          *(u32x4*)(Bs + (size_t)l * 136 + ch * 8) = *(const u32x4*)(XBC + (size_t)(r0 + l) * 1024 + 512 + grp * 128 + ch * 8); }
#pragma unroll
      for (int it = 0; it < 8; ++it) { const int ch = c4 + 4 * it;
          const u32x4 vv = *(const u32x4*)(XBC + (size_t)(r0 + l) * 1024 + grp * 256 + ch * 8);
          bf16_t* vp = XT + (size_t)(ch * 8) * 136 + l;
          vp[0] = (bf16_t)(vv.x & 0xffff); vp[136] = (bf16_t)(vv.x >> 16); vp[272] = (bf16_t)(vv.y & 0xffff); vp[408] = (bf16_t)(vv.y >> 16);
          vp[544] = (bf16_t)(vv.z & 0xffff); vp[680] = (bf16_t)(vv.z >> 16); vp[816] = (bf16_t)(vv.w & 0xffff); vp[952] = (bf16_t)(vv.w >> 16); } }
    __syncthreads();
    f32x16 x[4];
#pragma unroll
    for (int st = 0; st < 4; ++st) x[st] = zero16();
    bf16x8 qfr[8];
#pragma unroll
    for (int ks = 0; ks < 8; ++ks) qfr[ks] = *(const bf16x8*)(XBC + (size_t)(r0 + t) * 1024 + 768 + grp * 128 + ks * 16 + h2 * 8);
#pragma unroll
    for (int ks = 0; ks < 8; ++ks) {
#pragma unroll
        for (int st = 0; st < 4; ++st) { const bf16x8 a = *(const bf16x8*)(Bs + (size_t)(st * 32 + r) * 136 + ks * 16 + h2 * 8); x[st] = MFMA32(a, qfr[ks], x[st]); } }
    float ssq = 0.f;
#pragma unroll 1
    for (int hh = 0; hh < 4; ++hh) {
        const int head = grp * 4 + hh;
        f32x16 ysum = zero16();
#pragma unroll 1
        for (int d = 0; d < 2; ++d) {
            const size_t sit = (size_t)((b * 2 + grp) * 2 + d) * 34 + chunk_j<128>(false, c, d);
            bf16x8 h0f[8];
#pragma unroll
            for (int ks = 0; ks < 8; ++ks) h0f[ks] = *(const bf16x8*)(ST + sit * 32768 + (size_t)(hh * 64 + pp * 32 + r) * 128 + ks * 16 + h2 * 8);
            const float* acd = ac + (d * 4 + hh) * 128; const float* dtd = dtv + (d * 4 + hh) * 128;
            const float at = acd[t], atl = at * LOG2E;
            f32x16 acc = zero16(), acc2 = zero16();
#pragma unroll
            for (int st = 0; st < 4; ++st) {
                if (d ? (st < tt) : (st > tt)) continue;
#pragma unroll
                for (int sb = 0; sb < 2; ++sb) { f32x16 wv;
#pragma unroll
                    for (int e = 0; e < 8; ++e) { const int i = 8 * sb + e, s = st * 32 + crow(i, h2); const bool valid = d ? (s >= t) : (s <= t);
                        wv[i] = valid ? x[st][i] * __builtin_amdgcn_exp2f(atl - dtd[s]) : 0.f; }
                    const bf16x8 pb = pack8(wv, sb);
                    const bf16x8 a = ld_tr2(XT + (size_t)(hh * 64 + pp * 32 + r) * 136 + st * 32 + sb * 16 + 4 * h2); acc = MFMA32(a, pb, acc); } }
#pragma unroll
            for (int ks = 0; ks < 8; ++ks) acc2 = MFMA32(h0f[ks], qfr[ks], acc2);
            const float ea = __expf(at);
#pragma unroll
            for (int i = 0; i < 16; ++i) ysum[i] += acc[i] + ea * acc2[i];
        }
        const float skp = p.d_skip[head];
#pragma unroll
        for (int g = 0; g < 4; ++g) { const int pcol = pp * 32 + 8 * g + 4 * h2;
            const u32x2 zz = *(const u32x2*)(P + (size_t)(r0 + t) * NP1 + 1536 + head * 64 + pcol);
            float yv[4];
            const float zf[4] = {lo16(zz.x), hi16(zz.x), lo16(zz.y), hi16(zz.y)};
#pragma unroll
            for (int e = 0; e < 4; ++e) { const float xv = bf2f(XT[(size_t)(hh * 64 + pcol + e) * 136 + t]); yv[e] = (ysum[4 * g + e] + skp * xv) * silu_f(zf[e]); ssq += yv[e] * yv[e]; }
            u32x2 wv2; wv2.x = pk2(yv[0], yv[1]); wv2.y = pk2(yv[2], yv[3]);
            *(u32x2*)(Y + (size_t)(r0 + t) * D + 512 + head * 64 + pcol) = wv2; }
    }
    ssq += __shfl_xor(ssq, 32);
    if (h2 == 0) red[pp * 128 + t] = ssq;
    __syncthreads();
    const float rstd = rsqrtf((red[t] + red[128 + t]) * (1.f / 256.f) + EPS);
#pragma unroll
    for (int hh = 0; hh < 4; ++hh)
#pragma unroll
        for (int g = 0; g < 4; ++g) { const int head = grp * 4 + hh, pcol = pp * 32 + 8 * g + 4 * h2;
            bf16_t* yp = Y + (size_t)(r0 + t) * D + 512 + head * 64 + pcol; const u32x2 yy = *(const u32x2*)yp; const f32x4 gn = *(const f32x4*)(p.d_norm_g + head * 64 + pcol);
            u32x2 wv2; wv2.x = pk2(lo16(yy.x) * rstd * gn[0], hi16(yy.x) * rstd * gn[1]); wv2.y = pk2(lo16(yy.y) * rstd * gn[2], hi16(yy.y) * rstd * gn[3]);
            *(u32x2*)yp = wv2; }
    __syncthreads();
}

#define XB_TMO      128
#define XB_XCNT(j)  (256  + 64 * (j))
#define XB_XSUB(j)  (1280 + 64 * (j))
#define XB_XGEN(j)  (2304 + 64 * (j))
#define XB_TOP      3328
#define XB_TOPGEN   3392
#define XCD_BAR_WORDS 3456
#define XB_SPIN_CAP (1u << 18)

__device__ __forceinline__ unsigned xb_ld(unsigned* p)              { return __hip_atomic_load(p, __ATOMIC_RELAXED, __HIP_MEMORY_SCOPE_AGENT); }
__device__ __forceinline__ unsigned xb_add(unsigned* p, unsigned v) { return __hip_atomic_fetch_add(p, v, __ATOMIC_RELAXED, __HIP_MEMORY_SCOPE_AGENT); }
__device__ __forceinline__ unsigned xb_xcc_id() { return (unsigned)__builtin_amdgcn_s_getreg((3 << 11) | 20) & 0xFu; }
#define XB_SPIN(cond, bar) do { unsigned _sp = 0; while (cond) { __builtin_amdgcn_s_sleep(1); \
    if ((++_sp & 255u) == 0u) { if (xb_ld(&(bar)[XB_TMO])) break; if (_sp > XB_SPIN_CAP) { atomicAdd(&(bar)[XB_TMO], 1u); break; } } } } while (0)

struct XcdBarrier {
    unsigned* bar; unsigned x;
    volatile LAS unsigned* st;
};

__device__ __forceinline__ XcdBarrier xcd_barrier_post(unsigned* bar, volatile LAS unsigned* st) {
    XcdBarrier b; b.bar = bar; b.x = xb_xcc_id(); b.st = st;
    if (threadIdx.x == 0) (void)xb_add(&bar[XB_XCNT(b.x)], 1u);
    return b;
}
__device__ __forceinline__ void xcd_barrier_complete(unsigned* bar, unsigned x, unsigned& nloc, unsigned& nx) {
    const unsigned G = gridDim.x * gridDim.y * gridDim.z;
    unsigned sum, cnt, mine, sp = 0u;
    for (;;) {
        sum = 0u; cnt = 0u; mine = 0u;
#pragma unroll
        for (unsigned j = 0; j < 16; ++j) { const unsigned c = xb_ld(&bar[XB_XCNT(j)]); sum += c; cnt += (c > 0u) ? 1u : 0u; mine = (j == x) ? c : mine; }
        if (sum == G) break;
        __builtin_amdgcn_s_sleep(1);
        if ((++sp & 255u) == 0u) { if (xb_ld(&bar[XB_TMO])) break; if (sp > XB_SPIN_CAP) { atomicAdd(&bar[XB_TMO], 1u); break; } }
    }
    nloc = mine > 0u ? mine : 1u; nx = cnt > 0u ? cnt : 1u;
}

__device__ __forceinline__ void xcd_barrier(const XcdBarrier& b) {
    asm volatile("s_waitcnt vmcnt(0)" ::: "memory");
    __syncthreads();
    if (threadIdx.x == 0) {
        unsigned* bar = b.bar;
        __builtin_amdgcn_s_waitcnt(0);
        unsigned nloc = b.st[0], nx = b.st[1];
        if (nloc == 0u) { xcd_barrier_complete(bar, b.x, nloc, nx); b.st[0] = nloc; b.st[1] = nx; }
        const unsigned old = xb_add(&bar[XB_XSUB(b.x)], 1u);
        const unsigned gen = old / nloc;
        if (old + 1u == (gen + 1u) * nloc) {
            __builtin_amdgcn_fence(__ATOMIC_RELEASE, "agent");
            asm volatile("s_waitcnt vmcnt(0)" ::: "memory");
            const unsigned og = xb_add(&bar[XB_TOP], 1u);
            const unsigned tg = og / nx;
            if (og + 1u == (tg + 1u) * nx) xb_add(&bar[XB_TOPGEN], 1u);
            else XB_SPIN(xb_ld(&bar[XB_TOPGEN]) == tg, bar);
            __builtin_amdgcn_fence(__ATOMIC_ACQUIRE, "agent");
            xb_add(&bar[XB_XGEN(b.x)], 1u);
            asm volatile("s_waitcnt vmcnt(0)" ::: "memory");
        } else {
            XB_SPIN(xb_ld(&bar[XB_XGEN(b.x)]) == gen, bar);
            __builtin_amdgcn_fence(__ATOMIC_ACQUIRE, "agent");
            asm volatile("s_waitcnt vmcnt(0)" ::: "memory");
        }
    }
    __syncthreads();
}


constexpr int N_PHASES = 24;
#define EN(n) (ONLYP < 0 || ONLYP == (n))
template <int ONLYP> __global__ void __launch_bounds__(NTHR) fwd_megakernel(Params p) {
    extern __shared__ __attribute__((aligned(16))) unsigned char lds[];
    cg::grid_group grid = cg::this_grid();
    unsigned char* ws = p.ws;
    bf16_t* UY = (bf16_t*)(ws + WS_UY); bf16_t* BIG = (bf16_t*)(ws + WS_BIG);
    bf16_t* Pb = (bf16_t*)(ws + WS_BIG + BIG_P); bf16_t* CV = (bf16_t*)(ws + WS_BIG + BIG_CV);
    bf16_t* Gb = (bf16_t*)(ws + WS_BIG + BIG_G); bf16_t* Ub = (bf16_t*)(ws + WS_BIG + BIG_U);
    float* hc = (float*)(ws + WS_HC); float* mods = (float*)(ws + WS_MODS); float* gates = (float*)(ws + WS_GATES);
    const float* m0 = mods; const float* m1 = mods + 9 * 6144;
    const int lo = p.ph_lo, hi = p.ph_hi;
    volatile LAS unsigned* xb_st = (volatile LAS unsigned*)(LAS unsigned char*)(lds + LDS_BYTES);
    if (threadIdx.x < 4) xb_st[threadIdx.x] = 0u;
    if (blockIdx.x == 0) for (int i = threadIdx.x; i < XCD_BAR_WORDS; i += NTHR) ((unsigned*)(ws + WS_BAR))[i] = 0u;
    __syncthreads();
    XcdBarrier xb; xb.bar = (unsigned*)(ws + WS_BAR); xb.x = 0; xb.st = xb_st;
#ifndef DUPMASK
#define DUPMASK 0u
#endif
#define PH(k) if (EN(k) && lo <= (k) && (k) < hi) for (int rep_ = 0; rep_ <= (int)((DUPMASK >> (k)) & 1u); ++rep_) if (rep_ == 0 || (grid.sync(), true))
#define SEAM(k) if (lo <= (k) && (k) + 1 < hi) { if ((k) == 0) { grid.sync(); xb = xcd_barrier_post((unsigned*)(ws + WS_BAR), xb_st); } else xcd_barrier(xb); }
    PH(0) { phase_prep(p, lds); }
    SEAM(0)
    PH(1) { { RNArgs a{p.x, p.ctx, nullptr, nullptr, nullptr, nullptr, nullptr, p.norm_g + 0 * D, m0 + 0 * D, m0 + 1 * D, UY, p.ev_w_in + NP0, 2320, gates, MT, 0}; phase_rownorm(a, lds); } }
    SEAM(1)
    PH(2) { run_gemm(lds, UY, (const bf16_t*)(ws + WS_WT_IN0), MT, NP0, D, Pb, NP0, 0, 0); }
    SEAM(2)
    PH(3) { rope_pass(lds, Pb, NP0, 8, 2); conv5_pass(Pb, NP0, 768, 512, p.b_conv, nullptr, 256, CV); }
    SEAM(3)
    PH(4) { for (int it = bidx(); it < 1088 + 2176; it += gridDim.x) {
            if (it < 1088) { int item = it;
                if (gridDim.x == 256 && it < 1024) {
                    const int rd = it >> 8, c = it & 255, x = c & 7, sl = c >> 3, g = rd * 4 + (x >> 1), w2 = (x & 1) * 32 + sl;
                    item = (g >> 1) * 128 + ((g & 1) * 4 + (w2 >> 4)) * 16 + (w2 & 15); }
                gqa_item(p, lds, item); }
            else mlstm_local_item(p, lds, it - 1088); } }
    SEAM(4)
    PH(5) { mlstm_scan(p, lds); }
    SEAM(5)
    PH(6) { for (int it = bidx(); it < 2176; it += gridDim.x) mlstm_out_item(p, lds, it); }
    SEAM(6)
    PH(7) { run_gemm(lds, UY, (const bf16_t*)(ws + WS_WT_OUT0), MT, D, D, BIG, D, 0, 0); }
    SEAM(7)
    PH(8) { { RNArgs a{p.x, p.ctx, BIG, p.norm_g + 1 * D, m0 + 2 * D, p.out, hc, p.norm_g + 2 * D, m0 + 3 * D, m0 + 4 * D, UY, nullptr, 0, nullptr, MT, 0}; phase_rownorm(a, lds); } }
    SEAM(8)
    PH(9) { run_gemm_act(lds, UY, (const bf16_t*)(ws + WS_WT_GU0), MT, Gb, p.ffn_conv); }
    SEAM(9)
    PH(11) { run_gemm(lds, Gb, (const bf16_t*)(ws + WS_WT_DN0), ML, D, FH, UY, D, 0, 0); }
    SEAM(11)
    PH(12) { RNArgs a{p.out, hc, UY, p.norm_g + 3 * D, m0 + 5 * D, p.out, hc, p.norm_g + 4 * D, m1 + 0 * D, m1 + 1 * D, UY, p.od_w_in + NP1, 3088, gates, ML, 0};
        const int nb = (int)gridDim.x, bb = (int)bidx();
        if (nb >= 64) { if (bb < 32) run_gemm(lds, Gb + (size_t)ML * FH, (const bf16_t*)(ws + WS_WT_DN0), MC, D, FH, UY + (size_t)ML * D, D, 0, 0, 32, bb); else phase_rownorm(a, lds, bb - 32, nb - 32); }
        else { run_gemm(lds, Gb + (size_t)ML * FH, (const bf16_t*)(ws + WS_WT_DN0), MC, D, FH, UY + (size_t)ML * D, D, 0, 0); __syncthreads(); phase_rownorm(a, lds); }
        if (lo <= 12 && 13 < hi) xcd_barrier(xb);
        RNArgs a2 = a; a2.nrows = MC; a2.row_begin = ML; phase_rownorm(a2, lds); }
    SEAM(12)
    PH(13) { run_gemm_in1(lds, UY, (const bf16_t*)(ws + WS_WT_IN1), Pb, CV, p.d_conv, p.d_conv_b); }
    SEAM(13)
    PH(14) { rope_pass(lds, Pb, NP1, 8, 8); vt_pass(p, lds); }
    SEAM(14)
    PH(15) { {
            const float lam_init = 0.8f - 0.6f * 0.7408182206817179f;
            float lam;
            { const int lane = tidx() & 63; float s1 = p.c_lambda[lane] * p.c_lambda[64 + lane], s2 = p.c_lambda[128 + lane] * p.c_lambda[192 + lane];
              s1 = wave_sum(s1); s2 = wave_sum(s2); lam = expf(s1) - expf(s2) + lam_init; }
            for (int it = bidx(); it < 512 + 1088; it += gridDim.x) {
                if (it < 512) { int item = it;
                    if (gridDim.x == 256) { const int rd = it >> 8, c = it & 255, x = c & 7, sl = c >> 3; item = ((rd * 16 + x * 2 + (sl >> 4)) << 4) | (sl & 15); }
                    diff_item(p, lds, item, lam, lam_init); }
                else ssd_local_item(p, lds, it - 512); }
        } }
    SEAM(15)
    PH(16) { ssd_scan(p, lds); }
    SEAM(16)
    PH(17) { for (int it = bidx(); it < 512; it += gridDim.x) ssd_out_item(p, lds, it); }
    SEAM(17)
    PH(18) { run_gemm(lds, UY, (const bf16_t*)(ws + WS_WT_OUT1), ML, D, D, BIG, D, 0, 0); }
    SEAM(18)
    PH(19) { { RNArgs a{p.out, hc, BIG, p.norm_g + 5 * D, m1 + 2 * D, p.out, hc, p.norm_g + 6 * D, m1 + 3 * D, m1 + 4 * D, UY, nullptr, 0, nullptr, ML, 0}; phase_rownorm(a, lds); } }
    SEAM(19)
    PH(20) { run_gemm_act(lds, UY, (const bf16_t*)(ws + WS_WT_GU1), ML, Gb, p.ffn_conv + 3 * FH); }
    SEAM(20)
    PH(22) { run_gemm(lds, Gb, (const bf16_t*)(ws + WS_WT_DN1), ML, D, FH, UY, D, 0, 0); }
    SEAM(22)
#ifdef EXTRA_SYNCS
    for (int q_ = 0; q_ < EXTRA_SYNCS; ++q_) grid.sync();
#endif
    PH(23) { { RNArgs a{p.out, hc, UY, p.norm_g + 7 * D, m1 + 5 * D, p.out, hc, nullptr, nullptr, nullptr, nullptr, nullptr, 0, nullptr, ML, 0}; phase_rownorm(a, lds); } }
    SEAM(23)
}

#ifndef MULTI_LAUNCH
#define MULTI_LAUNCH 0
#endif
template <int K> static void launch_phase(Params p, int grid, hipStream_t stream) {
    p.ph_lo = K; p.ph_hi = K + 1;
    static bool attr = false;
    if (!attr) { (void)hipFuncSetAttribute((const void*)fwd_megakernel<K>, hipFuncAttributeMaxDynamicSharedMemorySize, LDS_TOTAL); attr = true; }
    hipLaunchKernelGGL(fwd_megakernel<K>, dim3(grid), dim3(NTHR), LDS_TOTAL, stream, p);
}
template <int K> static void launch_all(const Params& p, int grid, hipStream_t stream) {
    if constexpr (K < N_PHASES) { launch_phase<K>(p, grid, stream); launch_all<K + 1>(p, grid, stream); }
}
extern "C" void kernel_launch(void* const* d_in, const int* in_sizes, int n_in, void* d_out, int out_size, void* d_ws, size_t ws_size, hipStream_t stream) {
    static int grid_blocks = 0;
    if (!grid_blocks) {
        int dev = 0, cus = 0;
        hipGetDevice(&dev);
        hipDeviceGetAttribute(&cus, hipDeviceAttributeMultiprocessorCount, dev);
        grid_blocks = cus;
        if (ws_size < WS_END) fprintf(stderr, "workspace too small: %zu < %zu\n", ws_size, (size_t)WS_END);
    }
    Params p{};
    const float** pp = (const float**)&p;
    for (int i = 0; i < 27; ++i) pp[i] = (const float*)d_in[i];
    p.out = (float*)d_out; p.ws = (unsigned char*)d_ws; p.ph_lo = 0; p.ph_hi = N_PHASES;
#if MULTI_LAUNCH
    launch_all<0>(p, grid_blocks, stream);
#else
    static bool attr = false;
    if (!attr) {
        int per_cu = 0;
        if (hipFuncSetAttribute((const void*)fwd_megakernel<-1>, hipFuncAttributeMaxDynamicSharedMemorySize, LDS_TOTAL) != hipSuccess) fprintf(stderr, "hipFuncSetAttribute failed\n");
        hipOccupancyMaxActiveBlocksPerMultiprocessor(&per_cu, (const void*)fwd_megakernel<-1>, NTHR, LDS_TOTAL);
        if (per_cu < 1) fprintf(stderr, "occupancy query says %d\n", per_cu);
        attr = true;
    }
    void* args[] = {&p};
    hipError_t e = hipLaunchCooperativeKernel((void*)fwd_megakernel<-1>, dim3(grid_blocks), dim3(NTHR), args, LDS_TOTAL, stream);
    if (e != hipSuccess) fprintf(stderr, "cooperative launch failed: %s (grid %d)\n", hipGetErrorString(e), grid_blocks);
#endif
}
```
